# Optimizing an MI355X kernel written in HIP

```python
import numpy as np
import jax, jax.numpy as jnp
from jax import lax

D_MODEL = 2048
BATCH = 4
SEQ = 2048
DEPTH = 4

N_EVEN = (DEPTH + 1) // 2
N_ODD = DEPTH // 2

A_HEADS = 8
A_DK = 128
A_DV = 128
A_QK = A_HEADS * A_DK
A_WIDTH = A_HEADS * A_DV
B_HEADS = 8
B_DK = 128
B_DV = 128
B_QK = B_HEADS * B_DK
B_WIDTH = B_HEADS * B_DV
CONV_K = 4
CHUNK = 64
EVEN_IN = 2 * A_QK + 2 * A_WIDTH + 2 * B_QK + 2 * B_WIDTH + 2 * B_HEADS
EVEN_OUT = A_WIDTH + B_WIDTH

C_HEADS = 16
C_GROUPS = 4
C_HPG = C_HEADS // C_GROUPS
C_DK = 128
C_DV = 128
C_Q = C_HEADS * C_DK
C_KV = C_GROUPS * C_DK
CMP_LEN = 32
CMP_STRIDE = 16
SEL_BLOCK = 64
N_SEL = 8
WINDOW = 512
Q_BLOCK = 128
SEL_Q_BLOCK = 64
SEL_FORCE = 1e4
ODD_IN = C_Q + 6 * C_KV + 3 * C_HEADS
ODD_OUT = C_HEADS * C_DV

D_FF = -(-8 * D_MODEL // (3 * 256)) * 256
NORM_EPS = 1e-6
NEG_INF = -1e30

kernel_name = 'hybrid_hgrn2_gdn_nsa_sandwich'


def rmsnorm(x, g):
    xf = x.astype(jnp.float32)
    y = xf * lax.rsqrt(jnp.mean(xf * xf, axis=-1, keepdims=True) + NORM_EPS)
    return (y * g.astype(jnp.float32)).astype(x.dtype)


def l2norm(x):
    return x * lax.rsqrt(jnp.sum(x * x, axis=-1, keepdims=True) + NORM_EPS)


def masked_softmax(s, mask):
    return jax.nn.softmax(jnp.where(mask, s, NEG_INF), axis=-1) * mask


def alibi_slopes(n):
    return jnp.asarray(2.0 ** (-8.0 * np.arange(1, n + 1) / n), jnp.float32)


def _chunks(x):
    b, t, h = x.shape[:3]
    x = x.reshape((b, t // CHUNK, CHUNK, h) + x.shape[3:])
    return jnp.moveaxis(x, 3, 1)


def _unchunk(o):
    n, b, h, c, d = o.shape
    return o.transpose(1, 0, 3, 2, 4).reshape(b, n * c, h, d)


def _causal_conv(x, w):
    return lax.conv_general_dilated(x, w[:, None, :], window_strides=(1,), padding=[(CONV_K - 1, 0)],
                                    dimension_numbers=('NWC', 'WIO', 'NWC'), feature_group_count=x.shape[-1])


def _hgrn2(q, f_logit, i, lb):
    b_, t_, h_, dk = q.shape
    dv = i.shape[-1]
    f = lb + (1.0 - lb) * jax.nn.sigmoid(f_logit)
    log_f = jnp.log(f)
    k = 1.0 - f
    xs = tuple(jnp.moveaxis(_chunks(a), 2, 0) for a in (q, k, i, log_f))
    tril = jnp.tril(jnp.ones((CHUNK, CHUNK), bool))[:, :, None]

    def step(S, inp):
        qn, kn, vn, ln = inp
        b = jnp.cumsum(ln, axis=2)
        decay = jnp.exp(jnp.where(tril, b[:, :, :, None, :] - b[:, :, None, :, :], -jnp.inf))
        intra = jnp.einsum('bhtd,bhsd,bhtsd->bhts', qn, kn, decay)
        o = jnp.einsum('bhts,bhse->bhte', intra, vn) + jnp.einsum('bhtd,bhde->bhte', qn * jnp.exp(b), S)
        b_end = b[:, :, -1:, :]
        S = jnp.exp(b_end[:, :, 0, :, None]) * S + jnp.einsum('bhsd,bhse->bhde', kn * jnp.exp(b_end - b), vn)
        return S, o

    S0 = jnp.zeros((b_, h_, dk, dv), jnp.float32)
    _, o = lax.scan(step, S0, xs)
    return _unchunk(o)


def _gated_delta(q, k, v, beta, log_decay):
    b_, t_, h_, dk = q.shape
    dv = v.shape[-1]
    qc, kc, vc = _chunks(q), _chunks(k), _chunks(v)
    bc = _chunks(beta)
    gc = jnp.cumsum(_chunks(log_decay), axis=-1)
    eye = jnp.eye(CHUNK, dtype=bool)
    tril = jnp.tril(jnp.ones((CHUNK, CHUNK), bool))
    decay = jnp.exp(jnp.where(tril, gc[..., :, None] - gc[..., None, :], -jnp.inf))
    kb = kc * bc[..., None]
    L = jnp.where(tril & ~eye, jnp.einsum('bhncd,bhnsd->bhncs', kb, kc) * decay, 0.0)
    rhs = jnp.concatenate([vc * bc[..., None], kb * jnp.exp(gc)[..., None]], axis=-1)
    sol = lax.linalg.triangular_solve(L + eye, rhs, left_side=True, lower=True, unit_diagonal=True)
    u, w = sol[..., :dv], sol[..., dv:]
    qk = jnp.einsum('bhncd,bhnsd->bhncs', qc, kc) * decay
    xs = tuple(jnp.moveaxis(a, 2, 0) for a in (qc, kc, u, w, qk, gc))

    def step(S, inp):
        qn, kn, un, wn, qkn, gn = inp
        v_new = un - jnp.einsum('bhcd,bhde->bhce', wn, S)
        o = (jnp.einsum('bhcd,bhde->bhce', qn * jnp.exp(gn)[..., None], S)
             + jnp.einsum('bhcs,bhse->bhce', qkn, v_new))
        g_end = gn[..., -1:]
        S = (jnp.exp(g_end)[..., None] * S
             + jnp.einsum('bhcd,bhce->bhde', kn * jnp.exp(g_end - gn)[..., None], v_new))
        return S, o

    S0 = jnp.zeros((b_, h_, dk, dv), jnp.float32)
    _, o = lax.scan(step, S0, xs)
    return _unchunk(o)


def _even_mixer(u, w_in, lb, conv_w, a_log, dt_bias, hgrn_g, gdn_g, w_out):
    b_, t_, _ = u.shape
    z = (u @ w_in).astype(jnp.float32)
    cuts = [int(c) for c in np.cumsum([A_QK, A_QK, A_WIDTH, A_WIDTH, B_QK, B_QK, B_WIDTH, B_WIDTH, B_HEADS])]
    aq, af, ai, ag, bq, bk, bv, bg, ba, bb = jnp.split(z, cuts, axis=-1)
    o_a = _hgrn2(aq.reshape(b_, t_, A_HEADS, A_DK), af.reshape(b_, t_, A_HEADS, A_DK),
                 ai.reshape(b_, t_, A_HEADS, A_DV), lb)
    o_a = rmsnorm(o_a, hgrn_g) * jax.nn.silu(ag.reshape(b_, t_, A_HEADS, A_DV))
    qkv = jax.nn.silu(_causal_conv(jnp.concatenate([bq, bk, bv], axis=-1), conv_w.astype(jnp.float32)))
    bq, bk, bv = jnp.split(qkv, [B_QK, 2 * B_QK], axis=-1)
    q = l2norm(bq.reshape(b_, t_, B_HEADS, B_DK)) * (B_DK ** -0.5)
    k = l2norm(bk.reshape(b_, t_, B_HEADS, B_DK))
    beta = jax.nn.sigmoid(bb)
    log_decay = -jnp.exp(a_log.astype(jnp.float32)) * jax.nn.softplus(ba + dt_bias.astype(jnp.float32))
    o_b = _gated_delta(q, k, bv.reshape(b_, t_, B_HEADS, B_DV), beta, log_decay)
    o_b = rmsnorm(o_b, gdn_g) * jax.nn.silu(bg.reshape(b_, t_, B_HEADS, B_DV))
    o = jnp.concatenate([o_a.reshape(b_, t_, A_WIDTH), o_b.reshape(b_, t_, B_WIDTH)], axis=-1)
    return o.astype(u.dtype) @ w_out


def _nsa_mixer(u, w_in, cmp_pos, cmp_w1, cmp_w2, w_out):
    b_, t_, _ = u.shape
    G, HP = C_GROUPS, C_HPG
    z = (u @ w_in).astype(jnp.float32)
    cuts = [C_Q + j * C_KV for j in range(7)]
    q, kc, vc, ks, vs, kw, vw, gl = jnp.split(z, cuts, axis=-1)
    kv = lambda a: a.reshape(b_, t_, G, C_DK)
    kc, vc, ks, vs, kw, vw = (kv(a) for a in (kc, vc, ks, vs, kw, vw))
    qg = q.reshape(b_, t_, G, HP, C_DK).transpose(0, 2, 3, 1, 4) * (C_DK ** -0.5)
    gates = jax.nn.sigmoid(gl.reshape(b_, t_, G, HP, 3)).transpose(0, 2, 3, 1, 4)
    slopes = alibi_slopes(C_HEADS).reshape(G, HP)
    tpos = jnp.arange(t_)

    n_cmp = (t_ - CMP_LEN) // CMP_STRIDE + 1
    cstart = jnp.arange(n_cmp) * CMP_STRIDE
    cidx = cstart[:, None] + jnp.arange(CMP_LEN)[None, :]

    def compress(a, pos, w1, w2):
        blk = a[:, cidx] + pos[None, None, :, None, :]
        blk = blk.transpose(0, 1, 3, 2, 4).reshape(b_, n_cmp, G, CMP_LEN * C_DK)
        return jax.nn.silu(blk @ w1) @ w2

    k_cmp = compress(kc, cmp_pos[0], cmp_w1[0], cmp_w2[0])
    v_cmp = compress(vc, cmp_pos[1], cmp_w1[1], cmp_w2[1])
    dist_c = tpos[:, None] - (cstart + CMP_LEN - 1)[None, :]
    s_c = jnp.einsum('bghtd,bjgd->bghtj', qg, k_cmp) - slopes[:, :, None, None] * dist_c
    p_c = masked_softmax(s_c, dist_c >= 0)
    o_cmp = jnp.einsum('bghtj,bjge->bghte', p_c, v_cmp)

    n_blk = t_ // SEL_BLOCK
    n_sel = min(N_SEL, n_blk)
    bstart = jnp.arange(n_blk) * SEL_BLOCK
    overlap = ((cstart[:, None] < bstart[None, :] + SEL_BLOCK)
               & (cstart[:, None] + CMP_LEN > bstart[None, :])).astype(jnp.float32)
    imp = jnp.einsum('bghtj,ji->bgti', p_c, overlap)
    cur = (tpos // SEL_BLOCK)[:, None]
    bi = jnp.arange(n_blk)[None, :]
    forced = (bi == 0) | (bi == cur) | (bi == cur - 1)
    score = jnp.where(forced, SEL_FORCE, jnp.where(bi > cur, -SEL_FORCE, imp))
    _, sel_idx = lax.top_k(score, n_sel)

    ks_blocks = ks.reshape(b_, n_blk, SEL_BLOCK, G, C_DK).transpose(0, 3, 1, 2, 4)
    vs_blocks = vs.reshape(b_, n_blk, SEL_BLOCK, G, C_DV).transpose(0, 3, 1, 2, 4)
    nqb = t_ // SEL_Q_BLOCK
    q_b = qg.reshape(b_, G, HP, nqb, SEL_Q_BLOCK, C_DK).transpose(3, 0, 1, 2, 4, 5)
    idx_b = sel_idx.reshape(b_, G, nqb, SEL_Q_BLOCK, n_sel).transpose(2, 0, 1, 3, 4)
    t_b = tpos.reshape(nqb, SEL_Q_BLOCK)
    gather = jax.vmap(jax.vmap(lambda blocks, ix: blocks[ix]))
    n_keys = n_sel * SEL_BLOCK

    def sel_block(args):
        qb, ib, tb = args
        kg = gather(ks_blocks, ib).reshape(b_, G, SEL_Q_BLOCK, n_keys, C_DK)
        vg = gather(vs_blocks, ib).reshape(b_, G, SEL_Q_BLOCK, n_keys, C_DV)
        kpos = (ib[..., None] * SEL_BLOCK + jnp.arange(SEL_BLOCK)).reshape(b_, G, SEL_Q_BLOCK, n_keys)
        dist = tb[None, None, :, None] - kpos
        s = (jnp.einsum('bghqd,bgqkd->bghqk', qb, kg)
             - slopes[None, :, :, None, None] * dist[:, :, None])
        p = masked_softmax(s, (dist >= 0)[:, :, None])
        return jnp.einsum('bghqk,bgqke->bghqe', p, vg)

    o_slc = lax.map(sel_block, (q_b, idx_b, t_b))
    o_slc = o_slc.transpose(1, 2, 3, 0, 4, 5).reshape(b_, G, HP, t_, C_DV)

    nwb = t_ // Q_BLOCK
    band = jnp.arange(nwb)[:, None] * Q_BLOCK + jnp.arange(Q_BLOCK + WINDOW)[None, :]
    pad = ((0, 0), (0, 0), (WINDOW, 0), (0, 0))
    kb = jnp.pad(kw.transpose(0, 2, 1, 3), pad)[:, :, band]
    vb = jnp.pad(vw.transpose(0, 2, 1, 3), pad)[:, :, band]
    kpos = band - WINDOW
    dist_w = tpos.reshape(nwb, Q_BLOCK)[:, :, None] - kpos[:, None, :]
    valid_w = (dist_w >= 0) & (dist_w < WINDOW) & (kpos[:, None, :] >= 0)
    qw = qg.reshape(b_, G, HP, nwb, Q_BLOCK, C_DK)
    s_w = jnp.einsum('bghnqd,bgnkd->bghnqk', qw, kb) - slopes[:, :, None, None, None] * dist_w
    p_w = masked_softmax(s_w, valid_w)
    o_win = jnp.einsum('bghnqk,bgnke->bghnqe', p_w, vb).reshape(b_, G, HP, t_, C_DV)

    o = gates[..., 0:1] * o_cmp + gates[..., 1:2] * o_slc + gates[..., 2:3] * o_win
    o = o.transpose(0, 3, 1, 2, 4).reshape(b_, t_, ODD_OUT)
    return o.astype(u.dtype) @ w_out


def _swiglu(u, w_gu, w_down):
    gate, up = jnp.split(u @ w_gu, 2, axis=-1)
    return (jax.nn.silu(gate) * up) @ w_down


def setup_inputs(seed: int = 0) -> dict:
    key = jax.random.key(seed)
    ks = jax.random.split(key, 20)
    f32 = jnp.float32
    nrm = lambda k, shape: jax.random.normal(k, shape, f32)
    w = lambda k, shape, fan_in: nrm(k, shape) * fan_in ** -0.5
    dt = jnp.exp(jax.random.uniform(ks[6], (N_EVEN, B_HEADS), f32, np.log(1e-3), np.log(1e-1)))
    return {
        'x': nrm(ks[0], (BATCH, SEQ, D_MODEL)),
        'norm_g': 1.0 + 0.05 * nrm(ks[1], (DEPTH, 4, D_MODEL)),
        'ab_w_in': w(ks[2], (N_EVEN, D_MODEL, EVEN_IN), D_MODEL),
        'hgrn_lb_logits': 0.5 * nrm(ks[3], (N_EVEN, A_QK)),
        'gdn_conv_w': w(ks[4], (N_EVEN, CONV_K, 2 * B_QK + B_WIDTH), CONV_K),
        'gdn_a_log': jnp.log(jax.random.uniform(ks[5], (N_EVEN, B_HEADS), f32, 1.0, 16.0)),
        'gdn_dt_bias': dt + jnp.log(-jnp.expm1(-dt)),
        'hgrn_norm_g': 1.0 + 0.05 * nrm(ks[7], (N_EVEN, A_DV)),
        'gdn_norm_g': 1.0 + 0.05 * nrm(ks[8], (N_EVEN, B_DV)),
        'ab_w_out': w(ks[9], (N_EVEN, EVEN_OUT, D_MODEL), EVEN_OUT),
        'nsa_w_in': w(ks[10], (N_ODD, D_MODEL, ODD_IN), D_MODEL),
        'nsa_cmp_pos': 0.1 * nrm(ks[11], (N_ODD, 2, CMP_LEN, C_DK)),
        'nsa_cmp_w1': w(ks[12], (N_ODD, 2, CMP_LEN * C_DK, C_DK), CMP_LEN * C_DK),
        'nsa_cmp_w2': w(ks[13], (N_ODD, 2, C_DK, C_DK), C_DK),
        'nsa_w_out': w(ks[14], (N_ODD, ODD_OUT, D_MODEL), ODD_OUT),
        'ffn_w_gu': w(ks[15], (DEPTH, D_MODEL, 2 * D_FF), D_MODEL),
        'ffn_w_down': w(ks[16], (DEPTH, D_FF, D_MODEL), D_FF),
    }


def reference(x, norm_g, ab_w_in, hgrn_lb_logits, gdn_conv_w, gdn_a_log, gdn_dt_bias, hgrn_norm_g,
              gdn_norm_g, ab_w_out, nsa_w_in, nsa_cmp_pos, nsa_cmp_w1, nsa_cmp_w2, nsa_w_out,
              ffn_w_gu, ffn_w_down):
    lb_all = jnp.cumsum(jax.nn.softmax(hgrn_lb_logits.astype(jnp.float32), axis=0), axis=0)
    lb_all = lb_all - lb_all[:1]
    h = x
    for layer in range(DEPTH):
        j = layer // 2
        u = rmsnorm(h, norm_g[layer, 0])
        if layer % 2 == 0:
            m = _even_mixer(u, ab_w_in[j], lb_all[j].reshape(A_HEADS, A_DK), gdn_conv_w[j], gdn_a_log[j],
                            gdn_dt_bias[j], hgrn_norm_g[j], gdn_norm_g[j], ab_w_out[j])
        else:
            m = _nsa_mixer(u, nsa_w_in[j], nsa_cmp_pos[j], nsa_cmp_w1[j], nsa_cmp_w2[j], nsa_w_out[j])
        h = h + rmsnorm(m, norm_g[layer, 1])
        u = rmsnorm(h, norm_g[layer, 2])
        h = h + rmsnorm(_swiglu(u, ffn_w_gu[layer], ffn_w_down[layer]), norm_g[layer, 3])
    return h
```

```cpp
#include <hip/hip_runtime.h>
#include <cstdio>
#include <cstdint>
#define MK_PER_PHASE 0
namespace pg8 {
#define PG8_LAS __attribute__((address_space(3)))
typedef unsigned short bf16_t;
typedef short bf16x8 __attribute__((ext_vector_type(8)));
typedef float f32x4 __attribute__((ext_vector_type(4)));
typedef unsigned u32x4 __attribute__((ext_vector_type(4)));
constexpr int BM = 256, BK = 64, HALF = 128, HTB = HALF * BK * 2  , STAGE_BYTES = 8 * HTB, NXCD = 8, WGM = 8;

__host__ __device__ __forceinline__ int lds_byte(int r, int c) { const int st = (r >> 4) * 2 + (c >> 5), rr = r & 15, cc = c & 31, ob = rr * 64 + cc * 2; return st * 1024 + (ob ^ (((ob >> 9) & 1) << 5)); }
__host__ __device__ __forceinline__ void stage_rc(int b, int& R, int& C) { const int st = b / 1024, sb = b % 1024, swz = sb ^ (((sb >> 9) & 1) << 5); R = (st >> 1) * 16 + swz / 64; C = (st & 1) * 32 + (swz % 64) / 2; }
__host__ __device__ __forceinline__ int perm32(int rho) { const int n = rho >> 4, i = rho & 15; return 8 * (i >> 2) + 4 * n + (i & 3); }

struct Unit { int pm, pn; };
struct Gemm { const bf16_t* A; const bf16_t* Bt; int M, N, K; };

struct StaticOrder {
    int nM, nN, nwg, G, c;
    __host__ __device__ void init(int M, int N, int G_, int c_) { nM = M / BM; nN = N / BM; nwg = nM * nN; G = G_; c = c_; }
    __host__ __device__ bool next(int i, Unit& u) const {
        const long L = (long)i * G + c; if (L >= nwg) return false;
        int wgid = (int)L; { const int q = nwg / NXCD, r = nwg % NXCD, xcd = wgid % NXCD, off = wgid / NXCD; wgid = (xcd < r ? xcd * (q + 1) : r * (q + 1) + (xcd - r) * q) + off; }
        const int nig = WGM * nN, gid = wgid / nig, fm = gid * WGM, gsz = (nM - fm) < WGM ? (nM - fm) : WGM;
        u.pm = fm + ((wgid % nig) % gsz); u.pn = (wgid % nig) / gsz; return true;
    }
    __device__ __forceinline__ void a_ready(const Unit&) const {}
    __device__ __forceinline__ void done(const Unit&) const {}
};

__device__ __forceinline__ unsigned cvt_pk_bf16(float lo, float hi) { unsigned r; asm volatile("v_cvt_pk_bf16_f32 %0, %1, %2" : "=v"(r) : "v"(lo), "v"(hi)); return r; }
#ifndef GAS
#define GAS __attribute__((address_space(1)))
#endif

__device__ __forceinline__ float silu_f(float x) { return x * __builtin_amdgcn_rcpf(1.0f + __builtin_amdgcn_exp2f(x * -1.4426950408889634f)); }
struct EpiBf16Plain {
    static constexpr bool PERM = true, AFTER_DRAIN = false;
    GAS bf16_t* O; int ldc;
    __device__ __forceinline__ void operator()(const f32x4 (&acc)[2][2][4][2], const Unit& u, int wr, int wc, int fr, int fq) const {
        const int row0 = u.pm * BM + wr * 64 + fr, col0 = u.pn * BM + wc * 32 + 8 * fq;
#pragma unroll
        for (int ai = 0; ai < 2; ++ai)
#pragma unroll
            for (int m = 0; m < 4; ++m) { GAS bf16_t* rowp = O + (size_t)(row0 + ai * HALF + m * 16) * ldc + col0;
#pragma unroll
                for (int bj = 0; bj < 2; ++bj) { const f32x4 v0 = acc[ai][bj][m][0], v1 = acc[ai][bj][m][1];
                    u32x4 w; w.x = cvt_pk_bf16(v0[0], v0[1]); w.y = cvt_pk_bf16(v0[2], v0[3]); w.z = cvt_pk_bf16(v1[0], v1[1]); w.w = cvt_pk_bf16(v1[2], v1[3]);
                    *(GAS u32x4*)(rowp + bj * HALF) = w; } }
    }
};
struct EpiSwiglu {
    static constexpr bool PERM = true, AFTER_DRAIN = false;
    GAS bf16_t* O; int ldc;
    __device__ __forceinline__ void operator()(const f32x4 (&acc)[2][2][4][2], const Unit& u, int wr, int wc, int fr, int fq) const {
        const int row0 = u.pm * BM + wr * 64 + fr, col0 = u.pn * HALF + wc * 32 + 8 * fq;
#pragma unroll
        for (int ai = 0; ai < 2; ++ai)
#pragma unroll
            for (int m = 0; m < 4; ++m) { GAS bf16_t* rowp = O + (size_t)(row0 + ai * HALF + m * 16) * ldc + col0;
                const f32x4 g0 = acc[ai][0][m][0], g1 = acc[ai][0][m][1], u0 = acc[ai][1][m][0], u1 = acc[ai][1][m][1];
                u32x4 w;
                w.x = cvt_pk_bf16(silu_f(g0[0]) * u0[0], silu_f(g0[1]) * u0[1]); w.y = cvt_pk_bf16(silu_f(g0[2]) * u0[2], silu_f(g0[3]) * u0[3]);
                w.z = cvt_pk_bf16(silu_f(g1[0]) * u1[0], silu_f(g1[1]) * u1[1]); w.w = cvt_pk_bf16(silu_f(g1[2]) * u1[2], silu_f(g1[3]) * u1[3]);
                *(GAS u32x4*)rowp = w; }
    }
};
struct EpiF32 {
    static constexpr bool PERM = false, AFTER_DRAIN = false;
    GAS float* C; int ldc;
    __device__ __forceinline__ void operator()(const f32x4 (&acc)[2][2][4][2], const Unit& u, int wr, int wc, int fr, int fq) const {
        const int row0 = u.pm * BM + wr * 64 + fr, col0 = u.pn * BM + wc * 32 + 4 * fq;
#pragma unroll
        for (int ai = 0; ai < 2; ++ai)
#pragma unroll
            for (int m = 0; m < 4; ++m) { GAS float* rowp = C + (size_t)(row0 + ai * HALF + m * 16) * ldc + col0;
#pragma unroll
                for (int bj = 0; bj < 2; ++bj)
#pragma unroll
                    for (int n = 0; n < 2; ++n) *(GAS f32x4*)(rowp + bj * HALF + n * 16) = acc[ai][bj][m][n]; }
    }
};
template <class Epi, class Sched, bool ALIGN_EPI = false, bool SP2 = false>
__device__ __forceinline__ void gemm_phase(PG8_LAS unsigned char* lds, const Gemm g, const Sched& S, const Epi& E) {
    int tid_l = threadIdx.x; asm volatile("" : "+v"(tid_l));
    const char* gA_ = (const char*)(g.A); const char* gB_ = (const char*)(g.Bt); asm volatile("" : "+s"(gA_), "+s"(gB_));
    const int tid = tid_l, wid = __builtin_amdgcn_readfirstlane(tid >> 6), lane = tid & 63, wr = wid >> 2, wc = wid & 3, fr = lane & 15, fq = lane >> 4;
    const int K = g.K, nt = K / BK;
    unsigned voffA[2], voffB[2];
#pragma unroll
    for (int i = 0; i < 2; ++i) { int R, C; stage_rc(tid * 16 + i * 8192, R, C); const int Rb = Epi::PERM ? ((R & ~31) + perm32(R & 31)) : R;
        voffA[i] = (unsigned)(R * K + C) * 2u; voffB[i] = (unsigned)(Rb * K + C) * 2u; }
    const size_t kstep = (size_t)(BK * 2);
    const size_t hstep = (size_t)HALF * K * 2;
    const size_t tstep = 2 * hstep;
    const unsigned ldsw = (unsigned)wid * 1024u;
    const int aoff = lds_byte(wr * 64 + fr, fq * 8), boff = lds_byte(wc * 32 + fr, fq * 8);
#define PG8_SA(b, h) (((b) * 2 + (h)) * HTB)
#define PG8_SB(b, h) ((4 + (b) * 2 + (h)) * HTB)
#define PG8_STAGE(bufoff, gbase, voff) do { _Pragma("unroll") for (int _i = 0; _i < 2; ++_i) \
        __builtin_amdgcn_global_load_lds((const unsigned*)((const char*)(gbase) + (voff)[_i]), (PG8_LAS unsigned*)(lds + (bufoff) + ldsw + _i * 8192), 16, 0, 0); } while (0)
#define PG8_LDA(dst, b, h) do { _Pragma("unroll") for (int m = 0; m < 4; ++m) _Pragma("unroll") for (int k = 0; k < 2; ++k) dst[m][k] = *(const PG8_LAS bf16x8*)(lds + PG8_SA(b, h) + aoff + m * 2048 + k * 1024); } while (0)
#define PG8_LDB(dst, b, h) do { _Pragma("unroll") for (int n = 0; n < 2; ++n) _Pragma("unroll") for (int k = 0; k < 2; ++k) dst[n][k] = *(const PG8_LAS bf16x8*)(lds + PG8_SB(b, h) + boff + n * 2048 + k * 1024); } while (0)
#define PG8_MMA(ai, bj, At, Bt) do { __builtin_amdgcn_s_setprio(1); _Pragma("unroll") for (int m = 0; m < 4; ++m) _Pragma("unroll") for (int n = 0; n < 2; ++n) _Pragma("unroll") for (int k = 0; k < 2; ++k) \
        acc[ai][bj][m][n] = __builtin_amdgcn_mfma_f32_16x16x32_bf16(Bt[n][k], At[m][k], acc[ai][bj][m][n], 0, 0, 0); __builtin_amdgcn_s_setprio(0); } while (0)
#define PG8_WAIT_V(n) asm volatile("s_waitcnt vmcnt(" #n ")" ::: "memory")
#define PG8_WAIT_L(n) asm volatile("s_waitcnt lgkmcnt(" #n ")" ::: "memory")
#define PG8_BAR __builtin_amdgcn_s_barrier()
#define PG8_SCHED __builtin_amdgcn_sched_barrier(0)
    Unit cur, nxt; int ui = 0;
    if (!S.next(0, cur)) return;
    f32x4 acc[2][2][4][2];
#pragma unroll
    for (int a = 0; a < 2; ++a)
#pragma unroll
        for (int b = 0; b < 2; ++b)
#pragma unroll
            for (int m = 0; m < 4; ++m)
#pragma unroll
                for (int n = 0; n < 2; ++n) acc[a][b][m][n] = (f32x4){0.f, 0.f, 0.f, 0.f};
    bf16x8 At[4][2], B0[2][2], B1[2][2];
    const char* cA = gA_ + (size_t)cur.pm * tstep; const char* cB = gB_ + (size_t)cur.pn * tstep;
    S.a_ready(cur);
    if constexpr (SP2) {
        PG8_STAGE(PG8_SB(0, 0), cB, voffB); PG8_STAGE(PG8_SB(0, 1), cB + hstep, voffB); PG8_STAGE(PG8_SA(0, 0), cA, voffA); PG8_STAGE(PG8_SA(0, 1), cA + hstep, voffA);
        if (wr == 1) PG8_BAR;
        PG8_WAIT_V(2); PG8_BAR;
        PG8_STAGE(PG8_SB(1, 0), cB + kstep, voffB); PG8_STAGE(PG8_SA(1, 0), cA + kstep, voffA); PG8_STAGE(PG8_SB(1, 1), cB + hstep + kstep, voffB);
        PG8_WAIT_V(6); PG8_BAR;
    } else {
        PG8_STAGE(PG8_SB(0, 0), cB, voffB); PG8_STAGE(PG8_SA(0, 0), cA, voffA); PG8_STAGE(PG8_SB(0, 1), cB + hstep, voffB); PG8_STAGE(PG8_SA(0, 1), cA + hstep, voffA);
        if (wr == 1) PG8_BAR;
        PG8_WAIT_V(4); PG8_BAR;
        PG8_STAGE(PG8_SB(1, 0), cB + kstep, voffB); PG8_STAGE(PG8_SA(1, 0), cA + kstep, voffA); PG8_STAGE(PG8_SB(1, 1), cB + hstep + kstep, voffB);
        PG8_WAIT_V(6); PG8_BAR;
    }
    for (;;) {
        const bool has_next = S.next(ui + 1, nxt);
        const char* nA = has_next ? gA_ + (size_t)nxt.pm * tstep : cA; const char* nB = has_next ? gB_ + (size_t)nxt.pn * tstep : cB;
        for (int t = 0; t < nt; t += 2) {
            const bool last = (t == nt - 2);
            const char* a1 = cA + (size_t)(t + 1) * kstep;
            const char* a2 = last ? nA : cA + (size_t)(t + 2) * kstep; const char* b2 = last ? nB : cB + (size_t)(t + 2) * kstep;
            const char* a3 = a2 + kstep; const char* b3 = b2 + kstep;
            if (last && has_next) S.a_ready(nxt);
            if constexpr (SP2) {
            PG8_LDB(B0, 0, 0); PG8_LDB(B1, 0, 1); PG8_SCHED; PG8_LDA(At, 0, 0); PG8_STAGE(PG8_SA(1, 1), a1 + hstep, voffA);
            PG8_WAIT_V(8); PG8_WAIT_L(0); PG8_BAR; PG8_MMA(0, 0, At, B0); PG8_MMA(0, 1, At, B1); PG8_BAR; PG8_SCHED;
            PG8_LDA(At, 0, 1); PG8_STAGE(PG8_SB(0, 0), b2, voffB); PG8_STAGE(PG8_SB(0, 1), b2 + hstep, voffB); PG8_STAGE(PG8_SA(0, 0), a2, voffA);
            PG8_WAIT_V(8); PG8_WAIT_L(0); PG8_BAR; PG8_MMA(1, 0, At, B0); PG8_MMA(1, 1, At, B1); PG8_BAR; PG8_SCHED;
            PG8_LDB(B0, 1, 0); PG8_LDB(B1, 1, 1); PG8_SCHED; PG8_LDA(At, 1, 0); PG8_STAGE(PG8_SA(0, 1), a2 + hstep, voffA);
            PG8_WAIT_V(8); PG8_WAIT_L(0); PG8_BAR; PG8_MMA(0, 0, At, B0); PG8_MMA(0, 1, At, B1); PG8_BAR; PG8_SCHED;
            PG8_LDA(At, 1, 1); PG8_STAGE(PG8_SB(1, 0), b3, voffB); PG8_STAGE(PG8_SB(1, 1), b3 + hstep, voffB); PG8_STAGE(PG8_SA(1, 0), a3, voffA);
            PG8_WAIT_V(8); PG8_WAIT_L(0); PG8_BAR; PG8_MMA(1, 0, At, B0); PG8_MMA(1, 1, At, B1); PG8_BAR; PG8_SCHED;
            } else {
            PG8_LDB(B0, 0, 0); PG8_SCHED; PG8_LDA(At, 0, 0); PG8_STAGE(PG8_SA(1, 1), a1 + hstep, voffA);
            PG8_WAIT_L(8); PG8_BAR; PG8_WAIT_L(0); PG8_MMA(0, 0, At, B0); PG8_BAR; PG8_SCHED;
            PG8_LDB(B1, 0, 1); PG8_STAGE(PG8_SB(0, 0), b2, voffB);
            PG8_BAR; PG8_WAIT_L(0); PG8_MMA(0, 1, At, B1); PG8_BAR;
            PG8_LDA(At, 0, 1); PG8_STAGE(PG8_SA(0, 0), a2, voffA);
            PG8_BAR; PG8_WAIT_L(0); PG8_MMA(1, 0, At, B0); PG8_BAR; PG8_SCHED;
            PG8_STAGE(PG8_SB(0, 1), b2 + hstep, voffB);
            PG8_WAIT_V(6); PG8_BAR; PG8_MMA(1, 1, At, B1); PG8_BAR;
            PG8_LDB(B0, 1, 0); PG8_SCHED; PG8_LDA(At, 1, 0); PG8_STAGE(PG8_SA(0, 1), a2 + hstep, voffA);
            PG8_WAIT_L(8); PG8_BAR; PG8_WAIT_L(0); PG8_MMA(0, 0, At, B0); PG8_BAR; PG8_SCHED;
            PG8_LDB(B1, 1, 1); PG8_STAGE(PG8_SB(1, 0), b3, voffB);
            PG8_BAR; PG8_WAIT_L(0); PG8_MMA(0, 1, At, B1); PG8_BAR;
            PG8_LDA(At, 1, 1); PG8_STAGE(PG8_SA(1, 0), a3, voffA);
            PG8_BAR; PG8_WAIT_L(0); PG8_MMA(1, 0, At, B0); PG8_BAR; PG8_SCHED;
            PG8_STAGE(PG8_SB(1, 1), b3 + hstep, voffB);
            PG8_WAIT_V(6); PG8_BAR; PG8_MMA(1, 1, At, B1); PG8_BAR;
            }
        }
        if constexpr (ALIGN_EPI) { if (wr == 0) PG8_BAR; }
        if constexpr (!Epi::AFTER_DRAIN) { E(acc, cur, wr, wc, fr, fq); S.done(cur); }
        if (!has_next) break;
#pragma unroll
        for (int a = 0; a < 2; ++a)
#pragma unroll
            for (int b = 0; b < 2; ++b)
#pragma unroll
                for (int m = 0; m < 4; ++m)
#pragma unroll
                    for (int n = 0; n < 2; ++n) acc[a][b][m][n] = (f32x4){0.f, 0.f, 0.f, 0.f};
        cur = nxt; cA = nA; cB = nB; ++ui;
        if constexpr (ALIGN_EPI) { if (wr == 1) PG8_BAR; }
    }
    PG8_WAIT_V(0);
    if constexpr (!ALIGN_EPI) { if (wr == 0) PG8_BAR; }
    PG8_BAR;
    if constexpr (Epi::AFTER_DRAIN) { E.fused(acc, cur, wr, wc, fr, fq, lds, wid, lane); S.done(cur); }
#undef PG8_SA
#undef PG8_SB
#undef PG8_STAGE
#undef PG8_LDA
#undef PG8_LDB
#undef PG8_MMA
#undef PG8_WAIT_V
#undef PG8_WAIT_L
#undef PG8_BAR
#undef PG8_SCHED
}
}

constexpr int NWAVES = 8;
constexpr int NB = 4, T = 2048, M = NB * T, D = 2048, DFF = 5632;
constexpr int EVEN_IN = 8208, ODD_IN = 5168, ZE = 8192, ZO = 5120;
constexpr float EPS = 1e-6f;
#ifndef MK_PER_PHASE
#define MK_PER_PHASE 0
#endif
constexpr int N_PHASES = 37;

constexpr size_t MiB = 1u << 20;
constexpr size_t WS_CTL = 0, CTL_ZERO_BYTES = 1 * MiB;
constexpr size_t WS_WIN_E = 2 * MiB;
constexpr size_t WS_WOUT_E = 66 * MiB;
constexpr size_t WS_WIN_O = 82 * MiB;
constexpr size_t WS_WOUT_O = 122 * MiB;
constexpr size_t WS_WGU = 138 * MiB;
constexpr size_t WS_WDN = 314 * MiB;
constexpr size_t WS_U = 402 * MiB;
constexpr size_t WS_Z = 434 * MiB;
constexpr size_t WS_OMIX = 562 * MiB;
constexpr size_t WS_MM = 594 * MiB;
constexpr size_t WS_HID = 658 * MiB;
constexpr size_t WS_GATES = 746 * MiB;
constexpr size_t WS_CMP = 748 * MiB;
constexpr size_t WS_RS = 978 * MiB;
constexpr size_t WS_END = 1010 * MiB;
constexpr int CW_BAR = 4096;

constexpr int RING_BYTES = 131072, LDS_BYTES = 147456, LDSCTL_OFF = LDS_BYTES - 1024, MISC_OFF = LDSCTL_OFF + 320;

#ifndef GAS
#define GAS __attribute__((address_space(1)))
#endif
#define LAS __attribute__((address_space(3)))
typedef unsigned short bf16;
typedef unsigned v4u __attribute__((ext_vector_type(4)));
typedef unsigned v2u __attribute__((ext_vector_type(2)));
typedef float f32x4 __attribute__((ext_vector_type(4)));
typedef float f32x2v __attribute__((ext_vector_type(2)));
#define LDS_WAIT() asm volatile("s_waitcnt lgkmcnt(0)" ::: "memory")
#define VM_WAIT() asm volatile("s_waitcnt vmcnt(0)" ::: "memory")
__device__ __forceinline__ unsigned f2bf(float f) { unsigned u = __builtin_bit_cast(unsigned, f); return (u + 0x7fffu + ((u >> 16) & 1u)) >> 16; }
__device__ __forceinline__ unsigned pk2s(float lo, float hi) { return f2bf(lo) | (f2bf(hi) << 16); }
__device__ __forceinline__ unsigned pk2(float lo, float hi) { unsigned r; asm("v_cvt_pk_bf16_f32 %0, %1, %2" : "=v"(r) : "v"(lo), "v"(hi)); return r; }
__device__ __forceinline__ float bflo(unsigned w) { return __builtin_bit_cast(float, w << 16); }
__device__ __forceinline__ float bfhi(unsigned w) { return __builtin_bit_cast(float, w & 0xffff0000u); }
__device__ __forceinline__ float sigmoid_f(float x) { return __builtin_amdgcn_rcpf(1.0f + __builtin_amdgcn_exp2f(x * -1.4426950408889634f)); }
__device__ __forceinline__ float silu2_f(float x) { return x * __builtin_amdgcn_rcpf(1.0f + __builtin_amdgcn_exp2f(x * -1.4426950408889634f)); }
__device__ __forceinline__ float wave_sum(float v) {
#pragma unroll
    for (int o = 1; o < 64; o <<= 1) v += __shfl_xor(v, o);
    return v;
}
__device__ __forceinline__ float wave_max(float v) {
#pragma unroll
    for (int o = 1; o < 64; o <<= 1) v = fmaxf(v, __shfl_xor(v, o));
    return v;
}
#define PHASE_IDS() int tid = threadIdx.x; asm volatile("" : "+v"(tid)); const int lane = tid & 63, wave = __builtin_amdgcn_readfirstlane(tid >> 6); (void)lane; (void)wave
#define XB_TMO      128
#define XB_XCNT(j)  (256  + 64 * (j))
#define XB_XSUB(j)  (1280 + 64 * (j))
#define XB_XGEN(j)  (2304 + 64 * (j))
#define XB_TOP      3328
#define XB_TOPGEN   3392
#define XCD_BAR_WORDS 3456
#define XB_SPIN_CAP (1u << 22)

__device__ __forceinline__ unsigned xb_ld(unsigned* p)              { return __hip_atomic_load(p, __ATOMIC_RELAXED, __HIP_MEMORY_SCOPE_AGENT); }
__device__ __forceinline__ unsigned xb_add(unsigned* p, unsigned v) { return __hip_atomic_fetch_add(p, v, __ATOMIC_RELAXED, __HIP_MEMORY_SCOPE_AGENT); }
__device__ __forceinline__ unsigned xb_xcc_id() { return (unsigned)__builtin_amdgcn_s_getreg((3 << 11) | 20) & 0xFu; }
#define XB_SPIN(cond, bar) do { unsigned _sp = 0; while (cond) { __builtin_amdgcn_s_sleep(1); \
    if ((++_sp & 255u) == 0u) { if (xb_ld(&(bar)[XB_TMO])) break; if (_sp > XB_SPIN_CAP) { atomicAdd(&(bar)[XB_TMO], 1u); break; } } } } while (0)

struct XcdBarrier {
    unsigned* bar; unsigned x;
    volatile LAS unsigned* st;
};

__device__ __forceinline__ XcdBarrier xcd_barrier_post(unsigned* bar, volatile LAS unsigned* st) {
    XcdBarrier b; b.bar = bar; b.x = xb_xcc_id(); b.st = st;
    if (threadIdx.x == 0) (void)xb_add(&bar[XB_XCNT(b.x)], 1u);
    return b;
}
__device__ __forceinline__ void xcd_barrier_complete(unsigned* bar, unsigned x, unsigned& nloc, unsigned& nx) {
    const unsigned G = gridDim.x * gridDim.y * gridDim.z;
    unsigned sum, cnt, mine, sp = 0u;
    for (;;) {
        sum = 0u; cnt = 0u; mine = 0u;
#pragma unroll
        for (unsigned j = 0; j < 16; ++j) { const unsigned c = xb_ld(&bar[XB_XCNT(j)]); sum += c; cnt += (c > 0u) ? 1u : 0u; mine = (j == x) ? c : mine; }
        if (sum == G) break;
        __builtin_amdgcn_s_sleep(1);
        if ((++sp & 255u) == 0u) { if (xb_ld(&bar[XB_TMO])) break; if (sp > XB_SPIN_CAP) { atomicAdd(&bar[XB_TMO], 1u); break; } }
    }
    nloc = mine > 0u ? mine : 1u; nx = cnt > 0u ? cnt : 1u;
}

__device__ __forceinline__ void xcd_barrier(const XcdBarrier& b) {
    asm volatile("s_waitcnt vmcnt(0)" ::: "memory");
    __syncthreads();
    if (threadIdx.x == 0) {
        unsigned* bar = b.bar;
        __builtin_amdgcn_s_waitcnt(0);
        unsigned nloc = b.st[0], nx = b.st[1];
        if (nloc == 0u) { xcd_barrier_complete(bar, b.x, nloc, nx); b.st[0] = nloc; b.st[1] = nx; }
        const unsigned old = xb_add(&bar[XB_XSUB(b.x)], 1u);
        const unsigned gen = old / nloc;
        if (old + 1u == (gen + 1u) * nloc) {
            __builtin_amdgcn_fence(__ATOMIC_RELEASE, "agent");
            asm volatile("s_waitcnt vmcnt(0)" ::: "memory");
            const unsigned og = xb_add(&bar[XB_TOP], 1u);
            const unsigned tg = og / nx;
            if (og + 1u == (tg + 1u) * nx) xb_add(&bar[XB_TOPGEN], 1u);
            else XB_SPIN(xb_ld(&bar[XB_TOPGEN]) == tg, bar);
            __builtin_amdgcn_fence(__ATOMIC_ACQUIRE, "agent");
            xb_add(&bar[XB_XGEN(b.x)], 1u);
            asm volatile("s_waitcnt vmcnt(0)" ::: "memory");
        } else {
            XB_SPIN(xb_ld(&bar[XB_XGEN(b.x)]) == gen, bar);
            __builtin_amdgcn_fence(__ATOMIC_ACQUIRE, "agent");
            asm volatile("s_waitcnt vmcnt(0)" ::: "memory");
        }
    }
    __syncthreads();
}

struct Params {
    const GAS float* x; const GAS float* norm_g; const GAS float* ab_w_in; const GAS float* hgrn_lb; const GAS float* conv_w; const GAS float* a_log; const GAS float* dt_bias;
    const GAS float* hgrn_g; const GAS float* gdn_g; const GAS float* ab_w_out; const GAS float* nsa_w_in; const GAS float* cmp_pos; const GAS float* cmp_w1; const GAS float* cmp_w2;
    const GAS float* nsa_w_out; const GAS float* w_gu; const GAS float* w_dn;
    GAS float* out; GAS unsigned char* ws; int ph_lo, ph_hi;
};
template <class T> __device__ __forceinline__ T* gptr(T* q) {
#if defined(__HIP_DEVICE_COMPILE__)
    __builtin_assume(!__builtin_amdgcn_is_shared((const void*)q)); __builtin_assume(!__builtin_amdgcn_is_private((const void*)q));
#endif
    return q; }
#define GLOBAL_PARAMS(p) do { p.ws = gptr(p.ws); p.x = gptr(p.x); p.norm_g = gptr(p.norm_g); p.ab_w_in = gptr(p.ab_w_in); p.hgrn_lb = gptr(p.hgrn_lb); p.conv_w = gptr(p.conv_w); p.a_log = gptr(p.a_log); \
    p.dt_bias = gptr(p.dt_bias); p.hgrn_g = gptr(p.hgrn_g); p.gdn_g = gptr(p.gdn_g); p.ab_w_out = gptr(p.ab_w_out); p.nsa_w_in = gptr(p.nsa_w_in); p.cmp_pos = gptr(p.cmp_pos); p.cmp_w1 = gptr(p.cmp_w1); \
    p.cmp_w2 = gptr(p.cmp_w2); p.nsa_w_out = gptr(p.nsa_w_out); p.w_gu = gptr(p.w_gu); p.w_dn = gptr(p.w_dn); p.out = gptr(p.out); } while (0)

__device__ __forceinline__ void tr_item(const GAS float* W, int ldw, int K, GAS bf16* WT, int n0, int r0, int k0, LAS float* scr, int lane, const GAS float* gk) {
#pragma unroll 8
    for (int i = 0; i < 32; ++i) { const int kk = 2 * i + (lane >> 5); scr[kk * 33 + (lane & 31)] = W[(size_t)(k0 + kk) * ldw + n0 + (lane & 31)]; }
    LDS_WAIT(); asm volatile("" ::: "memory");
    const int c = lane & 7;
    f32x4 ga = (f32x4){1.f, 1.f, 1.f, 1.f}, gb = ga;
    if (gk) { ga = *(const GAS f32x4*)(gk + k0 + 8 * c); gb = *(const GAS f32x4*)(gk + k0 + 8 * c + 4); }
#pragma unroll
    for (int j = 0; j < 4; ++j) { const int n = (lane >> 3) + 8 * j; const LAS float* s = scr + (8 * c) * 33 + n;
        v4u o; o.x = pk2(s[0 * 33] * ga[0], s[1 * 33] * ga[1]); o.y = pk2(s[2 * 33] * ga[2], s[3 * 33] * ga[3]); o.z = pk2(s[4 * 33] * gb[0], s[5 * 33] * gb[1]); o.w = pk2(s[6 * 33] * gb[2], s[7 * 33] * gb[3]);
        *(GAS v4u*)(WT + (size_t)(r0 + n) * K + k0 + 8 * c) = o; }
    LDS_WAIT(); asm volatile("" ::: "memory");
}
__device__ __forceinline__ void tr_matrix(const GAS float* W, int ldw, int K, int ncols, GAS bf16* WT, int mode, LAS float* scr, int gw, int NGW, int lane, const GAS float* gk = nullptr) {
    const int nblk = ncols / 32, nitems = (K / 64) * nblk;
    for (int it = gw; it < nitems; it += NGW) {
        const int kb = it / nblk, nb = it % nblk, n0 = nb * 32;
        int r0 = n0;
        if (mode == 1) { r0 = (n0 < DFF) ? (n0 / 128) * 256 + (n0 % 128) : ((n0 - DFF) / 128) * 256 + 128 + ((n0 - DFF) % 128); }
        tr_item(W, ldw, K, WT, n0, r0, kb * 64, scr, lane, gk);
    }
}
__device__ __forceinline__ void conv_weight(const Params& p, int what, int idx, LAS float* scr, int gw, int NGW, int lane) {
    GAS unsigned char* ws = p.ws;
    if (what == 0) tr_matrix(p.ab_w_in + (size_t)idx * D * EVEN_IN, EVEN_IN, D, ZE, (GAS bf16*)(ws + WS_WIN_E) + (size_t)idx * ZE * D, 0, scr, gw, NGW, lane, p.norm_g + (size_t)((2 * idx) * 4 + 0) * D);
    else if (what == 1) tr_matrix(p.ab_w_out + (size_t)idx * D * D, D, D, D, (GAS bf16*)(ws + WS_WOUT_E) + (size_t)idx * D * D, 0, scr, gw, NGW, lane);
    else if (what == 2) tr_matrix(p.nsa_w_in + (size_t)idx * D * ODD_IN, ODD_IN, D, ZO, (GAS bf16*)(ws + WS_WIN_O) + (size_t)idx * ZO * D, 0, scr, gw, NGW, lane, p.norm_g + (size_t)((2 * idx + 1) * 4 + 0) * D);
    else if (what == 3) tr_matrix(p.nsa_w_out + (size_t)idx * D * D, D, D, D, (GAS bf16*)(ws + WS_WOUT_O) + (size_t)idx * D * D, 0, scr, gw, NGW, lane);
    else if (what == 4) tr_matrix(p.w_gu + (size_t)idx * D * 2 * DFF, 2 * DFF, D, 2 * DFF, (GAS bf16*)(ws + WS_WGU) + (size_t)idx * 2 * DFF * D, 1, scr, gw, NGW, lane, p.norm_g + (size_t)(idx * 4 + 2) * D);
    else tr_matrix(p.w_dn + (size_t)idx * DFF * D, D, DFF, D, (GAS bf16*)(ws + WS_WDN) + (size_t)idx * D * DFF, 0, scr, gw, NGW, lane);
}
__device__ __forceinline__ void p0_prologue(const Params& p0, LAS unsigned char* lds, bool all) {
    PHASE_IDS(); Params p = p0; asm volatile("" : "+s"(p.ws)); GLOBAL_PARAMS(p);
    const int gw = blockIdx.x * NWAVES + wave, NGW = gridDim.x * NWAVES;
    LAS float* scr = (LAS float*)(lds + wave * 16384);
    (void)all;
    for (int L = 3; L >= 0; --L) { const int j = L >> 1;
        conv_weight(p, 5, L, scr, gw, NGW, lane); conv_weight(p, 4, L, scr, gw, NGW, lane);
        conv_weight(p, (L & 1) ? 3 : 1, j, scr, gw, NGW, lane); conv_weight(p, (L & 1) ? 2 : 0, j, scr, gw, NGW, lane); }
}
template <int NX> __device__ __forceinline__ void gate_dots(const LAS float* su, const GAS float* wx, int ldw, int lane, GAS float* grow) {
    float acc[NX];
#pragma unroll
    for (int c = 0; c < NX; ++c) acc[c] = 0.f;
#pragma unroll 2
    for (int it = 0; it < 32; ++it) { const int k = it * 64 + lane; const float uu = su[k]; const GAS f32x4* wp = (const GAS f32x4*)(wx + (size_t)k * ldw);
#pragma unroll
        for (int c4 = 0; c4 < NX / 4; ++c4) { const f32x4 w = wp[c4]; acc[4 * c4 + 0] += uu * w[0]; acc[4 * c4 + 1] += uu * w[1]; acc[4 * c4 + 2] += uu * w[2]; acc[4 * c4 + 3] += uu * w[3]; } }
#pragma unroll
    for (int c = 0; c < NX; ++c) { const float s = wave_sum(acc[c]); if (lane == 0) grow[c] = s; }
}
template <int CTRL> __device__ __forceinline__ float dpp_mov0(float v) { return __builtin_bit_cast(float, __builtin_amdgcn_update_dpp(0, __builtin_bit_cast(int, v), CTRL, 0xf, 0xf, true)); }
__device__ __forceinline__ float wave_sum_fast(float v) {
    v += dpp_mov0<0xB1>(v); v += dpp_mov0<0x4E>(v); v += dpp_mov0<0x141>(v); v += dpp_mov0<0x140>(v);
    return __builtin_bit_cast(float, __builtin_amdgcn_readlane(__builtin_bit_cast(int, v), 0)) + __builtin_bit_cast(float, __builtin_amdgcn_readlane(__builtin_bit_cast(int, v), 16))
         + __builtin_bit_cast(float, __builtin_amdgcn_readlane(__builtin_bit_cast(int, v), 32)) + __builtin_bit_cast(float, __builtin_amdgcn_readlane(__builtin_bit_cast(int, v), 48));
}
template <bool HAS_MM, bool HAS_U, bool HIN_F32, bool HOUT_F32>
__device__ __forceinline__ void nrm_phase(const GAS float* hin, GAS float* hout, const GAS bf16* mm, const GAS float* g_res, GAS bf16* U, GAS float* RS) {
    PHASE_IDS(); const int gw = blockIdx.x * NWAVES + wave, NGW = gridDim.x * NWAVES;
    for (int row0 = gw; row0 < M; row0 += 2 * NGW) {
        const int row1 = row0 + NGW; const bool two = row1 < M; const int r1 = two ? row1 : row0;
        f32x4 ha[8], hb[8]; v2u ua_[8], ub_[8], wa[8], wb[8]; f32x4 gg[8]; float rsa = 1.f, rsb = 1.f;
        if (HIN_F32) { const GAS f32x4* pa = (const GAS f32x4*)(hin + (size_t)row0 * D) + lane; const GAS f32x4* pb = (const GAS f32x4*)(hin + (size_t)r1 * D) + lane;
#pragma unroll
          for (int j = 0; j < 8; ++j) { ha[j] = pa[64 * j]; hb[j] = pb[64 * j]; }
        } else { const GAS v2u* pa = (const GAS v2u*)(U + (size_t)row0 * D) + lane; const GAS v2u* pb = (const GAS v2u*)(U + (size_t)r1 * D) + lane; rsa = RS[row0]; rsb = RS[r1];
#pragma unroll
          for (int j = 0; j < 8; ++j) { ua_[j] = pa[64 * j]; ub_[j] = pb[64 * j]; } }
        if (HAS_MM) { const GAS v2u* ma = (const GAS v2u*)(mm + (size_t)row0 * D) + lane; const GAS v2u* mb = (const GAS v2u*)(mm + (size_t)r1 * D) + lane;
#pragma unroll
            for (int j = 0; j < 8; ++j) { wa[j] = ma[64 * j]; wb[j] = mb[64 * j]; }
#pragma unroll
            for (int j = 0; j < 8; ++j) gg[j] = ((const GAS f32x4*)g_res)[lane + 64 * j]; }
        __builtin_amdgcn_sched_barrier(0);
        if (!HIN_F32) { const float ia = __builtin_amdgcn_rcpf(rsa), ib = __builtin_amdgcn_rcpf(rsb);
#pragma unroll
          for (int j = 0; j < 8; ++j) { const v2u a = ua_[j], b2 = ub_[j]; ha[j] = (f32x4){bflo(a.x), bfhi(a.x), bflo(a.y), bfhi(a.y)} * ia; hb[j] = (f32x4){bflo(b2.x), bfhi(b2.x), bflo(b2.y), bfhi(b2.y)} * ib; } }
        if (HAS_MM) {
            float sa = 0.f, sb = 0.f;
#pragma unroll
            for (int j = 0; j < 8; ++j) { const float a0 = bflo(wa[j].x), a1 = bfhi(wa[j].x), a2 = bflo(wa[j].y), a3 = bfhi(wa[j].y), b0 = bflo(wb[j].x), b1 = bfhi(wb[j].x), b2 = bflo(wb[j].y), b3 = bfhi(wb[j].y);
                sa += (a0 * a0 + a1 * a1) + (a2 * a2 + a3 * a3); sb += (b0 * b0 + b1 * b1) + (b2 * b2 + b3 * b3); }
            sa = wave_sum_fast(sa); sb = wave_sum_fast(sb);
            const float ra = __builtin_amdgcn_rsqf(sa * (1.0f / D) + EPS), rb = __builtin_amdgcn_rsqf(sb * (1.0f / D) + EPS);
#pragma unroll
            for (int j = 0; j < 8; ++j) { const f32x4 g = gg[j];
                ha[j] = ha[j] + (f32x4){bflo(wa[j].x), bfhi(wa[j].x), bflo(wa[j].y), bfhi(wa[j].y)} * ra * g; hb[j] = hb[j] + (f32x4){bflo(wb[j].x), bfhi(wb[j].x), bflo(wb[j].y), bfhi(wb[j].y)} * rb * g; }
            if (HOUT_F32) { GAS f32x4* oa = (GAS f32x4*)(hout + (size_t)row0 * D) + lane; GAS f32x4* ob = (GAS f32x4*)(hout + (size_t)r1 * D) + lane;
#pragma unroll
                for (int j = 0; j < 8; ++j) { oa[64 * j] = ha[j]; if (two) ob[64 * j] = hb[j]; } }
        }
        if (HAS_U) {
            float sa = 0.f, sb = 0.f;
#pragma unroll
            for (int j = 0; j < 8; ++j) { sa += (ha[j][0] * ha[j][0] + ha[j][1] * ha[j][1]) + (ha[j][2] * ha[j][2] + ha[j][3] * ha[j][3]); sb += (hb[j][0] * hb[j][0] + hb[j][1] * hb[j][1]) + (hb[j][2] * hb[j][2] + hb[j][3] * hb[j][3]); }
            sa = wave_sum_fast(sa); sb = wave_sum_fast(sb);
            const float ra = __builtin_amdgcn_rsqf(sa * (1.0f / D) + EPS), rb = __builtin_amdgcn_rsqf(sb * (1.0f / D) + EPS);
            GAS v2u* ua = (GAS v2u*)(U + (size_t)row0 * D) + lane; GAS v2u* ub = (GAS v2u*)(U + (size_t)r1 * D) + lane;
#pragma unroll
            for (int j = 0; j < 8; ++j) { const f32x4 xa = ha[j] * ra, xb = hb[j] * rb;
                v2u w; w.x = pk2(xa[0], xa[1]); w.y = pk2(xa[2], xa[3]); ua[64 * j] = w; if (two) { v2u w2; w2.x = pk2(xb[0], xb[1]); w2.y = pk2(xb[2], xb[3]); ub[64 * j] = w2; } }
            if (lane == 0) { RS[row0] = ra; if (two) RS[row1] = rb; }
        }
    }
}

template <int CTRL> __device__ __forceinline__ float dpp_mov(float v) { return __builtin_bit_cast(float, __builtin_amdgcn_update_dpp(0, __builtin_bit_cast(int, v), CTRL, 0xf, 0xf, true)); }
__device__ __forceinline__ float row16_sum(float v) { v += dpp_mov<0xB1>(v); v += dpp_mov<0x4E>(v); v += dpp_mov<0x141>(v); v += dpp_mov<0x140>(v); return v; }
__device__ __forceinline__ void escan_slow(const Params& p0, LAS unsigned char* lds, int unit, int je) {
    PHASE_IDS(); Params p = p0; asm volatile("" : "+s"(p.ws)); GLOBAL_PARAMS(p);
    const int mixer = unit >> 5, b = (unit >> 3) & 3, h = unit & 7;
    LAS float* sQ = (LAS float*)lds; LAS float* sF = sQ + 4096; LAS float* sV = sF + 4096; LAS float* sO = sV + 4096; LAS float* sAB = sO + 4096;
    const GAS bf16* Z = (const GAS bf16*)(p.ws + WS_Z); const GAS float* gates = (const GAS float*)(p.ws + WS_GATES); GAS bf16* OMIX = (GAS bf16*)(p.ws + WS_OMIX);
    const int dgrp = lane & 15, egrp = wave * 4 + (lane >> 4), d0 = dgrp * 8, e0 = egrp * 4;
    float S[8][4];
#pragma unroll
    for (int dd = 0; dd < 8; ++dd)
#pragma unroll
        for (int ee = 0; ee < 4; ++ee) S[dd][ee] = 0.f;
    for (int t0 = 0; t0 < T; t0 += 32) {
        if (mixer == 0) {
            const int tt = tid >> 4, c8 = (tid & 15) * 8; const size_t m = (size_t)b * T + t0 + tt;
            const v4u qw = *(const GAS v4u*)(Z + m * ZE + h * 128 + c8), fw = *(const GAS v4u*)(Z + m * ZE + 1024 + h * 128 + c8), vw = *(const GAS v4u*)(Z + m * ZE + 2048 + h * 128 + c8);
            float q8[8] = {bflo(qw.x), bfhi(qw.x), bflo(qw.y), bfhi(qw.y), bflo(qw.z), bfhi(qw.z), bflo(qw.w), bfhi(qw.w)};
            float f8[8] = {bflo(fw.x), bfhi(fw.x), bflo(fw.y), bfhi(fw.y), bflo(fw.z), bfhi(fw.z), bflo(fw.w), bfhi(fw.w)};
            float v8[8] = {bflo(vw.x), bfhi(vw.x), bflo(vw.y), bfhi(vw.y), bflo(vw.z), bfhi(vw.z), bflo(vw.w), bfhi(vw.w)};
#pragma unroll
            for (int i = 0; i < 8; ++i) { const int ch = h * 128 + c8 + i;
                const float lb = je ? sigmoid_f(p.hgrn_lb[1024 + ch] - p.hgrn_lb[ch]) : 0.f;
                const float f = lb + (1.0f - lb) * sigmoid_f(f8[i]);
                sQ[tt * 128 + c8 + i] = q8[i]; sF[tt * 128 + c8 + i] = f; sV[tt * 128 + c8 + i] = v8[i]; }
        } else {
            for (int it = tid; it < 1536; it += 512) {
                const int tt = it / 48, cc = it % 48, which = cc >> 4, c8 = (cc & 15) * 8;
                const int zcol = 4096 + which * 1024 + h * 128 + c8, wcol = which * 1024 + h * 128 + c8;
                float acc[8];
#pragma unroll
                for (int i = 0; i < 8; ++i) acc[i] = 0.f;
#pragma unroll
                for (int kk = 0; kk < 4; ++kk) { const int tpos = t0 + tt - 3 + kk;
                    if (tpos >= 0) { const v4u zw = *(const GAS v4u*)(Z + ((size_t)b * T + tpos) * ZE + zcol); const GAS float* cw = p.conv_w + ((size_t)(je * 4 + kk)) * 3072 + wcol;
                        const f32x4 w0 = *(const GAS f32x4*)cw, w1 = *(const GAS f32x4*)(cw + 4);
                        acc[0] += w0[0] * bflo(zw.x); acc[1] += w0[1] * bfhi(zw.x); acc[2] += w0[2] * bflo(zw.y); acc[3] += w0[3] * bfhi(zw.y);
                        acc[4] += w1[0] * bflo(zw.z); acc[5] += w1[1] * bfhi(zw.z); acc[6] += w1[2] * bflo(zw.w); acc[7] += w1[3] * bfhi(zw.w); } }
                LAS float* dst = (which == 0 ? sQ : (which == 1 ? sF : sV)) + tt * 128 + c8;
#pragma unroll
                for (int i = 0; i < 8; ++i) dst[i] = silu2_f(acc[i]);
            }
            if (tid < 32) { const size_t m = (size_t)b * T + t0 + tid; const float ba = gates[m * 64 + h], bb = gates[m * 64 + 8 + h];
                const float xx = ba + p.dt_bias[je * 8 + h]; const float sp = xx > 20.f ? xx : __logf(1.0f + __expf(xx));
                const float ld = -__expf(p.a_log[je * 8 + h]) * sp; sAB[2 * tid] = __expf(ld); sAB[2 * tid + 1] = sigmoid_f(bb); }
            __syncthreads();
#pragma unroll 1
            for (int r = 0; r < 8; ++r) { const int pair = wave * 8 + r, tt = pair >> 1, which = pair & 1; LAS float* ptr = (which ? sF : sQ) + tt * 128;
                const float a0 = ptr[2 * lane], a1 = ptr[2 * lane + 1]; const float ss = wave_sum(a0 * a0 + a1 * a1);
                const float sc = (1.0f / sqrtf(ss + 1e-6f)) * (which ? 1.0f : 0.08838834764831845f); ptr[2 * lane] = a0 * sc; ptr[2 * lane + 1] = a1 * sc; }
        }
        __syncthreads();
#pragma unroll 4
        for (int tt = 0; tt < 32; ++tt) {
            const f32x4 qa = *(const LAS f32x4*)(sQ + tt * 128 + d0), qb = *(const LAS f32x4*)(sQ + tt * 128 + d0 + 4);
            const f32x4 fa = *(const LAS f32x4*)(sF + tt * 128 + d0), fb = *(const LAS f32x4*)(sF + tt * 128 + d0 + 4);
            const f32x4 v4 = *(const LAS f32x4*)(sV + tt * 128 + e0);
            const float q8[8] = {qa[0], qa[1], qa[2], qa[3], qb[0], qb[1], qb[2], qb[3]};
            const float f8[8] = {fa[0], fa[1], fa[2], fa[3], fb[0], fb[1], fb[2], fb[3]};
            float o4[4] = {0.f, 0.f, 0.f, 0.f};
            if (mixer == 0) {
#pragma unroll
                for (int dd = 0; dd < 8; ++dd) { const float kd = 1.0f - f8[dd];
#pragma unroll
                    for (int ee = 0; ee < 4; ++ee) { S[dd][ee] = f8[dd] * S[dd][ee] + kd * v4[ee]; o4[ee] += S[dd][ee] * q8[dd]; } }
            } else {
                const float a = sAB[2 * tt], beta = sAB[2 * tt + 1];
                float ks[4] = {0.f, 0.f, 0.f, 0.f};
#pragma unroll
                for (int dd = 0; dd < 8; ++dd)
#pragma unroll
                    for (int ee = 0; ee < 4; ++ee) { S[dd][ee] *= a; ks[ee] += f8[dd] * S[dd][ee]; }
#pragma unroll
                for (int ee = 0; ee < 4; ++ee) ks[ee] = row16_sum(ks[ee]);
                float dl[4];
#pragma unroll
                for (int ee = 0; ee < 4; ++ee) dl[ee] = beta * (v4[ee] - ks[ee]);
#pragma unroll
                for (int dd = 0; dd < 8; ++dd)
#pragma unroll
                    for (int ee = 0; ee < 4; ++ee) { S[dd][ee] += f8[dd] * dl[ee]; o4[ee] += S[dd][ee] * q8[dd]; }
            }
#pragma unroll
            for (int ee = 0; ee < 4; ++ee) o4[ee] = row16_sum(o4[ee]);
            if (dgrp == 0) *(LAS f32x4*)(sO + tt * 128 + e0) = (f32x4){o4[0], o4[1], o4[2], o4[3]};
        }
        __syncthreads();
#pragma unroll 1
        for (int r = 0; r < 4; ++r) { const int tt = wave * 4 + r; const size_t m = (size_t)b * T + t0 + tt;
            const float o0 = sO[tt * 128 + 2 * lane], o1 = sO[tt * 128 + 2 * lane + 1];
            const float ss = wave_sum(o0 * o0 + o1 * o1); const float rstd = 1.0f / sqrtf(ss * (1.0f / 128.0f) + EPS);
            const int gcol = (mixer ? 7168 : 3072) + h * 128 + 2 * lane; const unsigned gw2 = *(const GAS unsigned*)(Z + m * ZE + gcol);
            const GAS float* gn = (mixer ? p.gdn_g : p.hgrn_g) + je * 128 + 2 * lane;
            const float r0 = o0 * rstd * gn[0] * silu2_f(bflo(gw2)), r1 = o1 * rstd * gn[1] * silu2_f(bfhi(gw2));
            *(GAS unsigned*)(OMIX + m * D + mixer * 1024 + h * 128 + 2 * lane) = pk2(r0, r1); }
    }
    __syncthreads();
}

__device__ __forceinline__ void ocmp_slow(const Params& p0, LAS unsigned char* lds, int unit, int jo) {
    PHASE_IDS(); Params p = p0; asm volatile("" : "+s"(p.ws)); GLOBAL_PARAMS(p);
    const int kv = unit >> 7, b = (unit >> 5) & 3, g = (unit >> 3) & 3, jb = unit & 7;
    LAS float* sA = (LAS float*)lds;
    const GAS bf16* Z = (const GAS bf16*)(p.ws + WS_Z); GAS bf16* CMP = (GAS bf16*)(p.ws + WS_CMP);
    const GAS float* pos = p.cmp_pos + (size_t)(jo * 2 + kv) * 32 * 128; const GAS float* w1 = p.cmp_w1 + (size_t)(jo * 2 + kv) * 4096 * 128; const GAS float* w2 = p.cmp_w2 + (size_t)(jo * 2 + kv) * 128 * 128;
    const int n = tid & 127, rg = tid >> 7, zc = 2048 + kv * 512 + g * 128;
    float acc[4] = {0.f, 0.f, 0.f, 0.f};
    for (int l = 0; l < 32; ++l) {
        __syncthreads();
#pragma unroll
        for (int e = 0; e < 4; ++e) { const int idx = tid + 512 * e, r = idx >> 7, d = idx & 127, j = jb * 16 + r; float v = 0.f;
            if (j < 127) { const int tok = 16 * j + l; const unsigned short zz = Z[((size_t)b * T + tok) * ZO + zc + d]; v = bflo((unsigned)zz) + pos[l * 128 + d]; }
            sA[r * 128 + d] = v; }
        __syncthreads();
        const GAS float* wl = w1 + (size_t)(l * 128) * 128 + n;
#pragma unroll 4
        for (int k4 = 0; k4 < 32; ++k4) {
            const float wa = wl[(size_t)(4 * k4 + 0) * 128], wb = wl[(size_t)(4 * k4 + 1) * 128], wc = wl[(size_t)(4 * k4 + 2) * 128], wd = wl[(size_t)(4 * k4 + 3) * 128];
#pragma unroll
            for (int i = 0; i < 4; ++i) { const f32x4 a = *(const LAS f32x4*)(sA + (rg * 4 + i) * 128 + 4 * k4); acc[i] += a[0] * wa + a[1] * wb + a[2] * wc + a[3] * wd; }
        }
    }
    __syncthreads();
#pragma unroll
    for (int i = 0; i < 4; ++i) sA[(rg * 4 + i) * 128 + n] = silu2_f(acc[i]);
    __syncthreads();
    float o[4] = {0.f, 0.f, 0.f, 0.f};
#pragma unroll 4
    for (int k4 = 0; k4 < 32; ++k4) {
        const float wa = w2[(size_t)(4 * k4 + 0) * 128 + n], wb = w2[(size_t)(4 * k4 + 1) * 128 + n], wc = w2[(size_t)(4 * k4 + 2) * 128 + n], wd = w2[(size_t)(4 * k4 + 3) * 128 + n];
#pragma unroll
        for (int i = 0; i < 4; ++i) { const f32x4 a = *(const LAS f32x4*)(sA + (rg * 4 + i) * 128 + 4 * k4); o[i] += a[0] * wa + a[1] * wb + a[2] * wc + a[3] * wd; }
    }
#pragma unroll
    for (int i = 0; i < 4; ++i) { const int j = jb * 16 + rg * 4 + i; CMP[((size_t)((kv * 4 + b) * 4 + g) * 128 + j) * 128 + n] = (j < 127) ? (bf16)f2bf(o[i]) : (bf16)0; }
    __syncthreads();
}

template <bool F32ROW> __device__ __forceinline__ void dot4(const GAS void* row, const LAS float* sq, float (&d)[4]) {
    d[0] = d[1] = d[2] = d[3] = 0.f;
    if (F32ROW) { const GAS f32x4* r = (const GAS f32x4*)row;
#pragma unroll 4
        for (int c = 0; c < 32; ++c) { const f32x4 kv = r[c];
#pragma unroll
            for (int h = 0; h < 4; ++h) { const f32x4 q = *(const LAS f32x4*)(sq + h * 128 + 4 * c); d[h] += (kv[0] * q[0] + kv[1] * q[1]) + (kv[2] * q[2] + kv[3] * q[3]); } }
    } else { const GAS v4u* r = (const GAS v4u*)row;
#pragma unroll 4
        for (int c = 0; c < 16; ++c) { const v4u w = r[c];
            const float k0 = bflo(w.x), k1 = bfhi(w.x), k2 = bflo(w.y), k3 = bfhi(w.y), k4 = bflo(w.z), k5 = bfhi(w.z), k6 = bflo(w.w), k7 = bfhi(w.w);
#pragma unroll
            for (int h = 0; h < 4; ++h) { const f32x4 qa = *(const LAS f32x4*)(sq + h * 128 + 8 * c), qb = *(const LAS f32x4*)(sq + h * 128 + 8 * c + 4);
                d[h] += ((k0 * qa[0] + k1 * qa[1]) + (k2 * qa[2] + k3 * qa[3])) + ((k4 * qb[0] + k5 * qb[1]) + (k6 * qb[2] + k7 * qb[3])); } }
    }
}
__device__ __forceinline__ void oatt_slow(const Params& p0, LAS unsigned char* lds, int unit) {
    PHASE_IDS(); Params p = p0; asm volatile("" : "+s"(p.ws)); GLOBAL_PARAMS(p);
    const int t8 = unit & 255, g = (unit >> 8) & 3, b = unit >> 10, t = t8 * 8 + wave;
    LAS float* sq = (LAS float*)(lds + wave * 12288);
    LAS float* sp = sq + 512;
    const GAS bf16* Z = (const GAS bf16*)(p.ws + WS_Z); const GAS bf16* CMP = (const GAS bf16*)(p.ws + WS_CMP); const GAS float* gates = (const GAS float*)(p.ws + WS_GATES); GAS bf16* OMIX = (GAS bf16*)(p.ws + WS_OMIX);
    const size_t m = (size_t)b * T + t; const GAS bf16* zrow = Z + m * ZO; const float NEG = -__builtin_inff();
    float slope[4];
#pragma unroll
    for (int h = 0; h < 4; ++h) { const unsigned w = *(const GAS unsigned*)(zrow + (g * 4 + h) * 128 + 2 * lane); sq[h * 128 + 2 * lane] = bflo(w) * 0.08838834764831845f; sq[h * 128 + 2 * lane + 1] = bfhi(w) * 0.08838834764831845f;
        slope[h] = exp2f(-0.5f * (float)(g * 4 + h + 1)); }
    LDS_WAIT();
    const int ncv = t >= 31 ? ((t - 31) >> 4) + 1 : 0;
    const GAS bf16* CK = CMP + ((size_t)((0 * 4 + b) * 4 + g) * 128) * 128; const GAS bf16* CV = CMP + ((size_t)((1 * 4 + b) * 4 + g) * 128) * 128;
    float oc[4][2] = {{0.f, 0.f}, {0.f, 0.f}, {0.f, 0.f}, {0.f, 0.f}};
    {
        float sc[2][4];
#pragma unroll
        for (int jb = 0; jb < 2; ++jb) { const int j = jb * 64 + lane, jc = j < 126 ? j : 126; float d[4]; dot4<false>(CK + (size_t)jc * 128, sq, d);
#pragma unroll
            for (int h = 0; h < 4; ++h) sc[jb][h] = (j < ncv) ? d[h] - slope[h] * (float)(t - (16 * j + 31)) : NEG; }
#pragma unroll
        for (int h = 0; h < 4; ++h) { const float mx = wave_max(fmaxf(sc[0][h], sc[1][h]));
            const float ea = (lane < ncv) ? __expf(sc[0][h] - mx) : 0.f, eb = (64 + lane < ncv) ? __expf(sc[1][h] - mx) : 0.f;
            const float l = wave_sum(ea + eb); const float inv = ncv > 0 ? 1.0f / l : 0.f;
            sp[lane * 4 + h] = ea * inv; sp[(64 + lane) * 4 + h] = eb * inv; }
        LDS_WAIT();
        for (int j = 0; j < ncv; ++j) { const f32x4 p4 = *(const LAS f32x4*)(sp + 4 * j); const unsigned vw2 = *(const GAS unsigned*)(CV + (size_t)j * 128 + 2 * lane); const f32x2v v2 = {bflo(vw2), bfhi(vw2)};
#pragma unroll
            for (int h = 0; h < 4; ++h) { oc[h][0] += p4[h] * v2[0]; oc[h][1] += p4[h] * v2[1]; } }
    }
    const int cur = t >> 6;
    unsigned mask;
    {
        float score = -3.0e38f;
        if (lane < 32) { const int i = lane; int jlo = 4 * i - 1; if (jlo < 0) jlo = 0; int jhi = 4 * i + 3; if (jhi > 126) jhi = 126; float imp = 0.f;
            for (int j = jlo; j <= jhi; ++j) { const f32x4 p4 = *(const LAS f32x4*)(sp + 4 * j); imp += (p4[0] + p4[1]) + (p4[2] + p4[3]); }
            const bool forced = (i == 0) || (i == cur) || (i == cur - 1);
            score = forced ? 1.0e4f : (i > cur ? -1.0e4f : imp); }
        int rank = 0;
        for (int i2 = 0; i2 < 32; ++i2) { const float s2 = __shfl(score, i2); rank += ((s2 > score) || (s2 == score && i2 < lane)) ? 1 : 0; }
        const bool sel = (lane < 32) && (rank < 8) && (lane <= cur);
        mask = (unsigned)__ballot(sel);
    }
    LDS_WAIT();
    float os[4][2] = {{0.f, 0.f}, {0.f, 0.f}, {0.f, 0.f}, {0.f, 0.f}};
    {
        float smax[4] = {NEG, NEG, NEG, NEG}; int nb = 0;
        for (unsigned mm = mask; mm; mm &= mm - 1, ++nb) { const int i = __builtin_ctz(mm); const int kpos = 64 * i + lane; const int kc = kpos < t ? kpos : t; float d[4];
            dot4<false>(Z + ((size_t)b * T + kc) * ZO + 3072 + g * 128, sq, d);
            f32x4 s4;
#pragma unroll
            for (int h = 0; h < 4; ++h) { const float s = (kpos <= t) ? d[h] - slope[h] * (float)(t - kpos) : NEG; s4[h] = s; smax[h] = fmaxf(smax[h], s); }
            *(LAS f32x4*)(sp + (nb * 64 + lane) * 4) = s4; }
        const int nsel = nb;
#pragma unroll
        for (int h = 0; h < 4; ++h) smax[h] = wave_max(smax[h]);
        LDS_WAIT();
        float ls[4] = {0.f, 0.f, 0.f, 0.f};
        for (int r = 0; r < nsel; ++r) { f32x4 s4 = *(const LAS f32x4*)(sp + (r * 64 + lane) * 4);
#pragma unroll
            for (int h = 0; h < 4; ++h) { const float e = __expf(s4[h] - smax[h]); s4[h] = e; ls[h] += e; }
            *(LAS f32x4*)(sp + (r * 64 + lane) * 4) = s4; }
#pragma unroll
        for (int h = 0; h < 4; ++h) ls[h] = 1.0f / wave_sum(ls[h]);
        LDS_WAIT();
        nb = 0;
        for (unsigned mm = mask; mm; mm &= mm - 1, ++nb) { const int i = __builtin_ctz(mm); int kend = t - 64 * i; if (kend > 63) kend = 63;
            const GAS bf16* vb = Z + ((size_t)b * T + 64 * i) * ZO + 3584 + g * 128 + 2 * lane;
            for (int kk = 0; kk <= kend; ++kk) { const f32x4 p4 = *(const LAS f32x4*)(sp + (nb * 64 + kk) * 4); const unsigned w = *(const GAS unsigned*)(vb + (size_t)kk * ZO); const float v0 = bflo(w), v1 = bfhi(w);
#pragma unroll
                for (int h = 0; h < 4; ++h) { os[h][0] += p4[h] * v0; os[h][1] += p4[h] * v1; } } }
#pragma unroll
        for (int h = 0; h < 4; ++h) { os[h][0] *= ls[h]; os[h][1] *= ls[h]; }
    }
    LDS_WAIT();
    float ow[4][2] = {{0.f, 0.f}, {0.f, 0.f}, {0.f, 0.f}, {0.f, 0.f}};
    {
        const int w0 = t > 511 ? t - 511 : 0, nk = t - w0 + 1, nbat = (nk + 63) >> 6;
        float smax[4] = {NEG, NEG, NEG, NEG};
        for (int wb = 0; wb < nbat; ++wb) { const int idx = wb * 64 + lane; const int ic = idx < nk ? idx : nk - 1; const int kpos = w0 + ic; float d[4];
            dot4<false>(Z + ((size_t)b * T + kpos) * ZO + 4096 + g * 128, sq, d);
            f32x4 s4;
#pragma unroll
            for (int h = 0; h < 4; ++h) { const float s = (idx < nk) ? d[h] - slope[h] * (float)(t - kpos) : NEG; s4[h] = s; smax[h] = fmaxf(smax[h], s); }
            *(LAS f32x4*)(sp + idx * 4) = s4; }
#pragma unroll
        for (int h = 0; h < 4; ++h) smax[h] = wave_max(smax[h]);
        LDS_WAIT();
        float ls[4] = {0.f, 0.f, 0.f, 0.f};
        for (int wb = 0; wb < nbat; ++wb) { f32x4 s4 = *(const LAS f32x4*)(sp + (wb * 64 + lane) * 4);
#pragma unroll
            for (int h = 0; h < 4; ++h) { const float e = __expf(s4[h] - smax[h]); s4[h] = e; ls[h] += e; }
            *(LAS f32x4*)(sp + (wb * 64 + lane) * 4) = s4; }
#pragma unroll
        for (int h = 0; h < 4; ++h) ls[h] = 1.0f / wave_sum(ls[h]);
        LDS_WAIT();
        const GAS bf16* vb = Z + ((size_t)b * T + w0) * ZO + 4608 + g * 128 + 2 * lane;
        for (int kk = 0; kk < nk; ++kk) { const f32x4 p4 = *(const LAS f32x4*)(sp + kk * 4); const unsigned w = *(const GAS unsigned*)(vb + (size_t)kk * ZO); const float v0 = bflo(w), v1 = bfhi(w);
#pragma unroll
            for (int h = 0; h < 4; ++h) { ow[h][0] += p4[h] * v0; ow[h][1] += p4[h] * v1; } }
#pragma unroll
        for (int h = 0; h < 4; ++h) { ow[h][0] *= ls[h]; ow[h][1] *= ls[h]; }
    }
    LDS_WAIT();
#pragma unroll
    for (int h = 0; h < 4; ++h) { const GAS float* gl = gates + m * 64 + g * 12 + h * 3; const float g0 = sigmoid_f(gl[0]), g1 = sigmoid_f(gl[1]), g2 = sigmoid_f(gl[2]);
        const float r0 = g0 * oc[h][0] + g1 * os[h][0] + g2 * ow[h][0], r1 = g0 * oc[h][1] + g1 * os[h][1] + g2 * ow[h][1];
        *(GAS unsigned*)(OMIX + m * D + (g * 4 + h) * 128 + 2 * lane) = pk2(r0, r1); }
}

typedef short bf16x8v __attribute__((ext_vector_type(8)));
typedef short s16x4v __attribute__((ext_vector_type(4)));
typedef float f32x16 __attribute__((ext_vector_type(16)));
#define MFMA32(a, b, c) __builtin_amdgcn_mfma_f32_32x32x16_bf16((a), (b), (c), 0, 0, 0)
constexpr int KP = 272, VP = 136, VPC = 264;
constexpr int VR = 320;
constexpr int FL_K0 = 0, FL_V0 = 17408, FL_K1 = 37888, FL_V1 = 55296;
constexpr int CM_K = 0, CM_V = 34816;
constexpr int OA_MISC = 75776, OA_OT = 76800, OTP = 272;
__device__ __forceinline__ int crow(int reg, int hh) { return (reg & 3) + 8 * (reg >> 2) + 4 * hh; }
__device__ __forceinline__ bf16x8v pack8(float a0, float a1, float a2, float a3, float a4, float a5, float a6, float a7) {
    v4u q;
    asm volatile("s_nop 1\n\tv_cvt_pk_bf16_f32 %0, %4, %5\n\tv_cvt_pk_bf16_f32 %1, %6, %7\n\tv_cvt_pk_bf16_f32 %2, %8, %9\n\tv_cvt_pk_bf16_f32 %3, %10, %11\n\ts_nop 1"
                 : "=&v"(q[0]), "=&v"(q[1]), "=&v"(q[2]), "=&v"(q[3]) : "v"(a0), "v"(a1), "v"(a2), "v"(a3), "v"(a4), "v"(a5), "v"(a6), "v"(a7));
    return __builtin_bit_cast(bf16x8v, q);
}
__device__ __forceinline__ bf16x8v pack8m(float a0, float a1, float a2, float a3, float a4, float a5, float a6, float a7) {
    v4u q;
    asm volatile("s_nop 15\n\ts_nop 3\n\tv_cvt_pk_bf16_f32 %0, %4, %5\n\tv_cvt_pk_bf16_f32 %1, %6, %7\n\tv_cvt_pk_bf16_f32 %2, %8, %9\n\tv_cvt_pk_bf16_f32 %3, %10, %11\n\ts_nop 1"
                 : "=&v"(q[0]), "=&v"(q[1]), "=&v"(q[2]), "=&v"(q[3]) : "v"(a0), "v"(a1), "v"(a2), "v"(a3), "v"(a4), "v"(a5), "v"(a6), "v"(a7));
    return __builtin_bit_cast(bf16x8v, q);
}
struct TileRegs { v4u k0, k1, v0, v1; };
__device__ __forceinline__ void tile_load(TileRegs& R, const GAS bf16* Kg, const GAS bf16* Vg, int ld, int tid) {
    const int key = tid >> 4, c16 = tid & 15;
    R.k0 = *(const GAS v4u*)(Kg + (size_t)key * ld + c16 * 8);
    R.k1 = *(const GAS v4u*)(Kg + (size_t)(key + 32) * ld + c16 * 8);
    R.v0 = *(const GAS v4u*)(Vg + (size_t)(2 * key) * ld + c16 * 8);
    R.v1 = *(const GAS v4u*)(Vg + (size_t)(2 * key + 1) * ld + c16 * 8);
}
__device__ __forceinline__ void tile_store(const TileRegs& R, LAS unsigned char* Kb, LAS unsigned char* Vb, int vpitch, int vkeyoff, int tid) {
    const int key = tid >> 4, c16 = tid & 15;
    *(LAS v4u*)(Kb + key * KP + c16 * 16) = R.k0;
    *(LAS v4u*)(Kb + (key + 32) * KP + c16 * 16) = R.k1;
    LAS unsigned char* vb = Vb + (8 * c16) * vpitch + vkeyoff + key * 4;
    const unsigned a0 = R.v0.x, a1 = R.v0.y, a2 = R.v0.z, a3 = R.v0.w, b0 = R.v1.x, b1 = R.v1.y, b2 = R.v1.z, b3 = R.v1.w;
    *(LAS unsigned*)(vb + 0 * vpitch) = (a0 & 0xffffu) | (b0 << 16); *(LAS unsigned*)(vb + 1 * vpitch) = (a0 >> 16) | (b0 & 0xffff0000u);
    *(LAS unsigned*)(vb + 2 * vpitch) = (a1 & 0xffffu) | (b1 << 16); *(LAS unsigned*)(vb + 3 * vpitch) = (a1 >> 16) | (b1 & 0xffff0000u);
    *(LAS unsigned*)(vb + 4 * vpitch) = (a2 & 0xffffu) | (b2 << 16); *(LAS unsigned*)(vb + 5 * vpitch) = (a2 >> 16) | (b2 & 0xffff0000u);
    *(LAS unsigned*)(vb + 6 * vpitch) = (a3 & 0xffffu) | (b3 << 16); *(LAS unsigned*)(vb + 7 * vpitch) = (a3 >> 16) | (b3 & 0xffff0000u);
}
__device__ __forceinline__ void tile_store_rm(const TileRegs& R, LAS unsigned char* Kb, LAS unsigned char* Vb, int tid) {
    const int key = tid >> 4, c16 = tid & 15;
    *(LAS v4u*)(Kb + key * KP + c16 * 16) = R.k0;
    *(LAS v4u*)(Kb + (key + 32) * KP + c16 * 16) = R.k1;
    *(LAS v4u*)(Vb + (2 * key) * VR + c16 * 16) = R.v0;
    *(LAS v4u*)(Vb + (2 * key + 1) * VR + c16 * 16) = R.v1;
}
#define TRV_ISSUE_(A, va_, dt_) asm volatile( \
    "ds_read_b64_tr_b16 %0, %8 offset:%9\n\tds_read_b64_tr_b16 %1, %8 offset:%10\n\tds_read_b64_tr_b16 %2, %8 offset:%11\n\tds_read_b64_tr_b16 %3, %8 offset:%12\n\t" \
    "ds_read_b64_tr_b16 %4, %8 offset:%13\n\tds_read_b64_tr_b16 %5, %8 offset:%14\n\tds_read_b64_tr_b16 %6, %8 offset:%15\n\tds_read_b64_tr_b16 %7, %8 offset:%16" \
    : "=&v"(A[0]), "=&v"(A[1]), "=&v"(A[2]), "=&v"(A[3]), "=&v"(A[4]), "=&v"(A[5]), "=&v"(A[6]), "=&v"(A[7]) : "v"(va_), \
      "n"(64 * (dt_)), "n"(64 * (dt_) + 8 * VR), "n"(64 * (dt_) + 16 * VR), "n"(64 * (dt_) + 24 * VR), "n"(64 * (dt_) + 32 * VR), "n"(64 * (dt_) + 40 * VR), "n"(64 * (dt_) + 48 * VR), "n"(64 * (dt_) + 56 * VR) : "memory")
#define TRV_WAIT_(A, n_) asm volatile("s_waitcnt lgkmcnt(" #n_ ")" : "+v"(A[0]), "+v"(A[1]), "+v"(A[2]), "+v"(A[3]), "+v"(A[4]), "+v"(A[5]), "+v"(A[6]), "+v"(A[7]) :: "memory")
constexpr float QSC = 0.08838834764831845f;
constexpr float QSC2 = 0.08838834764831845f * 1.4426950408889634f;
template <int MODE>
__device__ __forceinline__ void flash_tile(const LAS unsigned char* Kb, const LAS unsigned char* Vb, const bf16x8v (&qf)[8], f32x16 (&o)[4], float& m, float& l,
                                           int kbase, int t, float slope2, bool selbit, bool edge, int r, int hh) {
    f32x16 S0, S1; const int lane_ = hh * 32 + r;
    const int kb4 = kbase + 4 * hh;
    const float bias0 = (MODE == 0 && !selbit) ? -1.0e30f : slope2 * (float)(kb4 - t);
#pragma unroll
    for (int reg = 0; reg < 16; ++reg) { const int c = (reg & 3) + 8 * (reg >> 2); S0[reg] = fmaf(slope2, (float)c, bias0); S1[reg] = fmaf(slope2, (float)(c + 32), bias0); }
    const LAS unsigned char* ka = Kb + r * KP + 16 * hh;
    bf16x8v kf[2][4];
#define LDK_(g, bu) { kf[bu][0] = *(const LAS bf16x8v*)(ka + 64 * (g)); kf[bu][1] = *(const LAS bf16x8v*)(ka + 32 * KP + 64 * (g)); kf[bu][2] = *(const LAS bf16x8v*)(ka + 64 * (g) + 32); kf[bu][3] = *(const LAS bf16x8v*)(ka + 32 * KP + 64 * (g) + 32); }
    LDK_(0, 0)
#pragma unroll
    for (int g = 0; g < 4; ++g) {
        if (g == 0) LDK_(1, 1) else if (g == 1) LDK_(2, 0) else if (g == 2) LDK_(3, 1)
        __builtin_amdgcn_sched_barrier(0);
        S0 = MFMA32(kf[g & 1][0], qf[2 * g], S0); S1 = MFMA32(kf[g & 1][1], qf[2 * g], S1); S0 = MFMA32(kf[g & 1][2], qf[2 * g + 1], S0); S1 = MFMA32(kf[g & 1][3], qf[2 * g + 1], S1);
        __builtin_amdgcn_sched_barrier(0);
    }
#undef LDK_
    const LAS unsigned char* va = Vb + (4 * hh + ((lane_ & 15) >> 2)) * VR + (16 * ((lane_ >> 4) & 1) + 4 * (lane_ & 3)) * 2;
    s16x4v vA[8], vB[8];
    TRV_ISSUE_(vA, va, 0);
    float mx = -1.0e30f;
    if (edge) {
#pragma unroll
        for (int reg = 0; reg < 16; ++reg) { const int k0 = kb4 + (reg & 3) + 8 * (reg >> 2), k1 = k0 + 32; bool v0, v1;
            if (MODE == 0) { v0 = (k0 <= t); v1 = (k1 <= t); } else { v0 = (k0 <= t) && (t - k0 < 512); v1 = (k1 <= t) && (t - k1 < 512); }
            S0[reg] = v0 ? S0[reg] : -1.0e30f; S1[reg] = v1 ? S1[reg] : -1.0e30f; }
    }
#pragma unroll
    for (int reg = 0; reg < 16; ++reg) mx = fmaxf(mx, fmaxf(S0[reg], S1[reg]));
    mx = fmaxf(mx, __shfl_xor(mx, 32));
    const float mn = (mx > m + 8.0f) ? mx : m, alpha = __builtin_amdgcn_exp2f(m - mn); m = mn;
    float ps = 0.f;
#pragma unroll
    for (int reg = 0; reg < 16; ++reg) { S0[reg] = __builtin_amdgcn_exp2f(S0[reg] - mn); S1[reg] = __builtin_amdgcn_exp2f(S1[reg] - mn); ps += S0[reg] + S1[reg]; }
    l = l * alpha + ps;
    if (__any(alpha != 1.0f)) {
#pragma unroll
        for (int dt = 0; dt < 4; ++dt)
#pragma unroll
            for (int reg = 0; reg < 16; ++reg) o[dt][reg] *= alpha;
    }
    bf16x8v pf[4];
    pf[0] = pack8(S0[0], S0[1], S0[2], S0[3], S0[4], S0[5], S0[6], S0[7]); pf[1] = pack8(S0[8], S0[9], S0[10], S0[11], S0[12], S0[13], S0[14], S0[15]);
    pf[2] = pack8(S1[0], S1[1], S1[2], S1[3], S1[4], S1[5], S1[6], S1[7]); pf[3] = pack8(S1[8], S1[9], S1[10], S1[11], S1[12], S1[13], S1[14], S1[15]);
#define PV4_(A, dt_) { o[dt_] = MFMA32(__builtin_shufflevector(A[0], A[1], 0, 1, 2, 3, 4, 5, 6, 7), pf[0], o[dt_]); o[dt_] = MFMA32(__builtin_shufflevector(A[2], A[3], 0, 1, 2, 3, 4, 5, 6, 7), pf[1], o[dt_]); \
        o[dt_] = MFMA32(__builtin_shufflevector(A[4], A[5], 0, 1, 2, 3, 4, 5, 6, 7), pf[2], o[dt_]); o[dt_] = MFMA32(__builtin_shufflevector(A[6], A[7], 0, 1, 2, 3, 4, 5, 6, 7), pf[3], o[dt_]); }
    TRV_ISSUE_(vB, va, 1); TRV_WAIT_(vA, 8); PV4_(vA, 0)
    TRV_ISSUE_(vA, va, 2); TRV_WAIT_(vB, 8); PV4_(vB, 1)
    TRV_ISSUE_(vB, va, 3); TRV_WAIT_(vA, 8); PV4_(vA, 2)
    TRV_WAIT_(vB, 0); PV4_(vB, 3)
#undef PV4_
}
template <int MODE>
__device__ __forceinline__ void flash_branch(LAS unsigned char* lds, const GAS bf16* Kg0, const GAS bf16* Vg0, unsigned tiles, const bf16x8v (&qf)[8], f32x16 (&o)[4], float& l_out,
                                             int t, float slope2, unsigned mask, int r, int hh, int tid, int tq) {
#pragma unroll
    for (int dt = 0; dt < 4; ++dt)
#pragma unroll
        for (int i = 0; i < 16; ++i) o[dt][i] = 0.f;
    float m = -1.0e20f, l = 0.f;
    unsigned rem = (unsigned)__builtin_amdgcn_readfirstlane((int)tiles);
#define POP_TILE() (rem ? (31 - __builtin_clz(rem)) : -1)
    int k0 = POP_TILE(); rem &= ~(1u << k0);
    int k1 = POP_TILE(); if (k1 >= 0) rem &= ~(1u << k1);
    TileRegs RA;
    tile_load(RA, Kg0 + (size_t)k0 * 64 * ZO, Vg0 + (size_t)k0 * 64 * ZO, ZO, tid); tile_store_rm(RA, lds + FL_K0, lds + FL_V0, tid);
    if (k1 >= 0) tile_load(RA, Kg0 + (size_t)k1 * 64 * ZO, Vg0 + (size_t)k1 * 64 * ZO, ZO, tid);
    __syncthreads();
    int par = 0;
    for (;;) {
        { const bool edge = (k0 == tq) || (MODE == 1 && k0 == tq - 8);
          const bool selb = ((mask >> k0) & 1u) != 0u;
          if (MODE == 1 || __any(selb)) flash_tile<MODE>(lds + (par ? FL_K1 : FL_K0), lds + (par ? FL_V1 : FL_V0), qf, o, m, l, k0 * 64, t, slope2, selb, edge, r, hh); }
        if (k1 < 0) break;
        tile_store_rm(RA, lds + (par ? FL_K0 : FL_K1), lds + (par ? FL_V0 : FL_V1), tid);
        __syncthreads();
        const int k2 = POP_TILE(); if (k2 >= 0) rem &= ~(1u << k2);
        if (k2 >= 0) tile_load(RA, Kg0 + (size_t)k2 * 64 * ZO, Vg0 + (size_t)k2 * 64 * ZO, ZO, tid);
        k0 = k1; k1 = k2; par ^= 1;
    }
    __syncthreads();
    l_out = l + __shfl_xor(l, 32);
}
__device__ __forceinline__ void oatt_fast(const Params& p0, LAS unsigned char* lds, int b, int g, int tq) {
    PHASE_IDS(); Params p = p0; asm volatile("" : "+s"(p.ws)); GLOBAL_PARAMS(p);
    const int r = lane & 31, hh = lane >> 5, tl = r & 7, h = r >> 3;
    const int t = tq * 64 + wave * 8 + tl;
    const GAS bf16* Z = (const GAS bf16*)(p.ws + WS_Z); const GAS bf16* CMP = (const GAS bf16*)(p.ws + WS_CMP); const GAS float* gates = (const GAS float*)(p.ws + WS_GATES); GAS bf16* OMIX = (GAS bf16*)(p.ws + WS_OMIX);
    const size_t m = (size_t)b * T + t;
    const float slope = exp2f(-0.5f * (float)(g * 4 + h + 1));
    bf16x8v qf[8];
    { const GAS bf16* qrow = Z + m * ZO + (g * 4 + h) * 128 + 8 * hh;
#pragma unroll
      for (int s = 0; s < 8; ++s) { const v4u w = *(const GAS v4u*)(qrow + 16 * s); v4u o_;
          o_.x = pk2(bflo(w.x) * QSC2, bfhi(w.x) * QSC2); o_.y = pk2(bflo(w.y) * QSC2, bfhi(w.y) * QSC2); o_.z = pk2(bflo(w.z) * QSC2, bfhi(w.z) * QSC2); o_.w = pk2(bflo(w.w) * QSC2, bfhi(w.w) * QSC2);
          qf[s] = __builtin_bit_cast(bf16x8v, o_); } }
    LAS unsigned* misc = (LAS unsigned*)(lds + OA_MISC);
    if (tid == 0) misc[0] = 0u;
    { const GAS bf16* CK = CMP + ((size_t)((0 * 4 + b) * 4 + g) * 128) * 128; const GAS bf16* CV = CMP + ((size_t)((1 * 4 + b) * 4 + g) * 128) * 128;
      TileRegs R;
      tile_load(R, CK, CV, 128, tid); tile_store(R, lds + CM_K, lds + CM_V, VPC, 0, tid);
      tile_load(R, CK + 64 * 128, CV + 64 * 128, 128, tid); tile_store(R, lds + CM_K + 64 * KP, lds + CM_V, VPC, 128, tid); }
    __syncthreads();
    f32x16 S[4];
#pragma unroll
    for (int sub = 0; sub < 4; ++sub)
#pragma unroll
        for (int i = 0; i < 16; ++i) S[sub][i] = 0.f;
    { const LAS unsigned char* ka = lds + CM_K + r * KP + 16 * hh; bf16x8v kf[2][4];
#define LDC_(s_, bu) { _Pragma("unroll") for (int sub = 0; sub < 4; ++sub) kf[bu][sub] = *(const LAS bf16x8v*)(ka + sub * 32 * KP + 32 * (s_)); }
      LDC_(0, 0)
#pragma unroll
      for (int s = 0; s < 8; ++s) {
          if (s < 7) { if (s & 1) LDC_(s + 1, 0) else LDC_(s + 1, 1) }
          __builtin_amdgcn_sched_barrier(0);
#pragma unroll
          for (int sub = 0; sub < 4; ++sub) S[sub] = MFMA32(kf[s & 1][sub], qf[s], S[sub]);
          __builtin_amdgcn_sched_barrier(0); }
#undef LDC_
    }
    const int ncv = t >= 31 ? ((t - 31) >> 4) + 1 : 0;
    { float mx = -1.0e30f;
#pragma unroll
      for (int sub = 0; sub < 4; ++sub)
#pragma unroll
          for (int reg = 0; reg < 16; ++reg) { const int j = 32 * sub + crow(reg, hh); const float s = S[sub][reg] + (slope * 1.4426950408889634f) * (float)(16 * j + 31 - t);
              S[sub][reg] = (j < ncv) ? s : -1.0e30f; mx = fmaxf(mx, S[sub][reg]); }
      mx = fmaxf(mx, __shfl_xor(mx, 32));
      float ps = 0.f;
#pragma unroll
      for (int sub = 0; sub < 4; ++sub)
#pragma unroll
          for (int reg = 0; reg < 16; ++reg) { const int j = 32 * sub + crow(reg, hh); const float e = (j < ncv) ? __builtin_amdgcn_exp2f(S[sub][reg] - mx) : 0.f; S[sub][reg] = e; ps += e; }
      ps += __shfl_xor(ps, 32);
      const float inv = ps > 0.f ? __builtin_amdgcn_rcpf(ps) : 0.f;
#pragma unroll
      for (int sub = 0; sub < 4; ++sub)
#pragma unroll
          for (int reg = 0; reg < 16; ++reg) S[sub][reg] *= inv; }
    float imp[16];
    { float prevLo = 0.f;
#pragma unroll
      for (int qq = 0; qq < 16; ++qq) { const int sub = qq >> 2, rq = qq & 3;
          const float A = (S[sub][4 * rq] + S[sub][4 * rq + 1]) + (S[sub][4 * rq + 2] + S[sub][4 * rq + 3]); const float Lq = S[sub][4 * rq + 3];
          const float Lo = __shfl_xor(Lq, 32);
          imp[qq] = A + (hh ? Lo : prevLo); prevLo = Lo; }
#pragma unroll
      for (int qq = 0; qq < 16; ++qq) { imp[qq] += __shfl_xor(imp[qq], 8); imp[qq] += __shfl_xor(imp[qq], 16); } }
    f32x16 o[4];
#pragma unroll
    for (int dt = 0; dt < 4; ++dt)
#pragma unroll
        for (int i = 0; i < 16; ++i) o[dt][i] = 0.f;
    { bf16x8v pf[8];
#pragma unroll
      for (int s2 = 0; s2 < 8; ++s2) { const int sub = s2 >> 1, b8 = 8 * (s2 & 1);
          pf[s2] = pack8(S[sub][b8], S[sub][b8 + 1], S[sub][b8 + 2], S[sub][b8 + 3], S[sub][b8 + 4], S[sub][b8 + 5], S[sub][b8 + 6], S[sub][b8 + 7]); }
      const LAS unsigned char* va = lds + CM_V + r * VPC + 8 * hh; bf16x8v vf[2][4];
#define LDCV_(g_, bu) { _Pragma("unroll") for (int j = 0; j < 4; ++j) { const int dt_ = (g_) >> 1, s2_ = 4 * ((g_) & 1) + j; const s16x4v lo = *(const LAS s16x4v*)(va + dt_ * 32 * VPC + 32 * s2_), hi = *(const LAS s16x4v*)(va + dt_ * 32 * VPC + 32 * s2_ + 16); vf[bu][j] = __builtin_shufflevector(lo, hi, 0, 1, 2, 3, 4, 5, 6, 7); } }
      LDCV_(0, 0)
#pragma unroll
      for (int g = 0; g < 8; ++g) {
          if (g < 7) { if (g & 1) LDCV_(g + 1, 0) else LDCV_(g + 1, 1) }
          __builtin_amdgcn_sched_barrier(0);
#pragma unroll
          for (int j = 0; j < 4; ++j) o[g >> 1] = MFMA32(vf[g & 1][j], pf[4 * (g & 1) + j], o[g >> 1]);
          __builtin_amdgcn_sched_barrier(0); }
#undef LDCV_
    }
    const GAS float* gl = gates + m * 64 + g * 12 + h * 3;
    const float g0 = sigmoid_f(gl[0]), g1 = sigmoid_f(gl[1]), g2 = sigmoid_f(gl[2]);
    LAS unsigned char* orow = lds + OA_OT + (wave * 32 + r) * OTP + 8 * hh;
#pragma unroll
    for (int dt = 0; dt < 4; ++dt)
#pragma unroll
        for (int q4 = 0; q4 < 4; ++q4) { v2u w; w.x = pk2(g0 * o[dt][4 * q4], g0 * o[dt][4 * q4 + 1]); w.y = pk2(g0 * o[dt][4 * q4 + 2], g0 * o[dt][4 * q4 + 3]); *(LAS v2u*)(orow + (32 * dt + 8 * q4) * 2) = w; }
    unsigned mask;
    if (tq <= 7) mask = (2u << tq) - 1u;
    else {
        float sc[32];
#pragma unroll
        for (int qq = 0; qq < 16; ++qq) { const float oth = __shfl_xor(imp[qq], 32); sc[2 * qq] = hh ? oth : imp[qq]; sc[2 * qq + 1] = hh ? imp[qq] : oth; }
#pragma unroll
        for (int i = 0; i < 32; ++i) { const bool forced = (i == 0) || (i == tq) || (i == tq - 1); sc[i] = forced ? 1.0e4f : (i > tq ? -1.0e4f : sc[i]); }
        int key[32];
#pragma unroll
        for (int i = 0; i < 32; ++i) key[i] = (__builtin_bit_cast(int, sc[i]) & ~31) | (31 - i);
        const int c8 = h * 2 + hh; unsigned part = 0u;
#pragma unroll
        for (int k = 0; k < 4; ++k) { int own = key[k];
#pragma unroll
            for (int cc = 1; cc < 8; ++cc) own = (c8 == cc) ? key[4 * cc + k] : own;
            int cnt = 0;
#pragma unroll
            for (int i2 = 0; i2 < 32; ++i2) cnt += (key[i2] > own) ? 1 : 0;
            const int idx = 4 * c8 + k; if (cnt < 8 && idx <= tq) part |= (1u << idx); }
        part |= (unsigned)__shfl_xor((int)part, 8); part |= (unsigned)__shfl_xor((int)part, 16); part |= (unsigned)__shfl_xor((int)part, 32);
        mask = part;
    }
    { unsigned um = mask; um |= __shfl_xor(um, 1); um |= __shfl_xor(um, 2); um |= __shfl_xor(um, 4); if (lane == 0) atomicOr((unsigned*)misc, um); }
    __syncthreads();
    const unsigned uni = misc[0];
    const unsigned upto = (tq >= 31) ? 0xffffffffu : ((2u << tq) - 1u);
    { float lsum; const GAS bf16* Kg0 = Z + (size_t)b * T * ZO + 3072 + g * 128; const GAS bf16* Vg0 = Z + (size_t)b * T * ZO + 3584 + g * 128;
#ifdef OATT_RP_SEL
      flash_branch<0>(lds, Kg0, Vg0, uni & upto, qf, o, lsum, t, slope * 1.4426950408889634f, mask, r, hh, tid, tq);
      if (lsum == -1.0f) misc[3] = __builtin_bit_cast(unsigned, o[0][0] + o[1][0] + o[2][0] + o[3][0]);
#endif
      flash_branch<0>(lds, Kg0, Vg0, uni & upto, qf, o, lsum, t, slope * 1.4426950408889634f, mask, r, hh, tid, tq);
      const float sc1 = g1 * __builtin_amdgcn_rcpf(lsum); v2u ow_[16];
#pragma unroll
      for (int dt = 0; dt < 4; ++dt)
#pragma unroll
          for (int q4 = 0; q4 < 4; ++q4) ow_[4 * dt + q4] = *(const LAS v2u*)(orow + (32 * dt + 8 * q4) * 2);
      __builtin_amdgcn_sched_barrier(0);
#pragma unroll
      for (int dt = 0; dt < 4; ++dt)
#pragma unroll
          for (int q4 = 0; q4 < 4; ++q4) { v2u w = ow_[4 * dt + q4];
              w.x = pk2(bflo(w.x) + sc1 * o[dt][4 * q4], bfhi(w.x) + sc1 * o[dt][4 * q4 + 1]); w.y = pk2(bflo(w.y) + sc1 * o[dt][4 * q4 + 2], bfhi(w.y) + sc1 * o[dt][4 * q4 + 3]);
              *(LAS v2u*)(orow + (32 * dt + 8 * q4) * 2) = w; } }
    { float lsum; const GAS bf16* Kg0 = Z + (size_t)b * T * ZO + 4096 + g * 128; const GAS bf16* Vg0 = Z + (size_t)b * T * ZO + 4608 + g * 128;
      const int klo = tq > 8 ? tq - 8 : 0; const unsigned wt = upto & ~((1u << klo) - 1u);
#ifdef OATT_RP_WIN
      flash_branch<1>(lds, Kg0, Vg0, wt, qf, o, lsum, t, slope * 1.4426950408889634f, 0u, r, hh, tid, tq);
      if (lsum == -1.0f) misc[3] = __builtin_bit_cast(unsigned, o[0][0] + o[1][0] + o[2][0] + o[3][0]);
#endif
      flash_branch<1>(lds, Kg0, Vg0, wt, qf, o, lsum, t, slope * 1.4426950408889634f, 0u, r, hh, tid, tq);
      const float sc2 = g2 * __builtin_amdgcn_rcpf(lsum); v2u ow_[16];
#pragma unroll
      for (int dt = 0; dt < 4; ++dt)
#pragma unroll
          for (int q4 = 0; q4 < 4; ++q4) ow_[4 * dt + q4] = *(const LAS v2u*)(orow + (32 * dt + 8 * q4) * 2);
      __builtin_amdgcn_sched_barrier(0);
#pragma unroll
      for (int dt = 0; dt < 4; ++dt)
#pragma unroll
          for (int q4 = 0; q4 < 4; ++q4) { v2u w = ow_[4 * dt + q4];
              w.x = pk2(bflo(w.x) + sc2 * o[dt][4 * q4], bfhi(w.x) + sc2 * o[dt][4 * q4 + 1]); w.y = pk2(bflo(w.y) + sc2 * o[dt][4 * q4 + 2], bfhi(w.y) + sc2 * o[dt][4 * q4 + 3]);
              *(LAS v2u*)(orow + (32 * dt + 8 * q4) * 2) = w; } }
    LDS_WAIT();
    { const int c16 = lane & 15, rsub = lane >> 4;
#pragma unroll
      for (int k = 0; k < 8; ++k) { const int rr = 4 * k + rsub, hr = rr >> 3, tr = rr & 7;
          const v4u w = *(const LAS v4u*)(lds + OA_OT + (wave * 32 + rr) * OTP + c16 * 16 - 0);
          *(GAS v4u*)(OMIX + ((size_t)b * T + tq * 64 + wave * 8 + tr) * D + (g * 4 + hr) * 128 + c16 * 8) = w; } }
    __syncthreads();
}

constexpr size_t WS_HREC = 752 * MiB; constexpr int HREC = 33024, H_QH = 0, H_KHT = 8192, H_VHT = 16384, H_OI = 24576, H_DE = 32768;
constexpr size_t WS_GREC = 834 * MiB; constexpr int GREC = 45056, G_NW = 0, G_QG = 8192, G_KGT = 16384, G_QKG = 24576, G_UU = 28672;
constexpr size_t WS_GEND = 922 * MiB;
constexpr size_t WS_OA = 924 * MiB;
__device__ __forceinline__ bf16x8v frag_nat(const LAS unsigned char* img, int row, int pitch, int k0, int hh) { return *(const LAS bf16x8v*)(img + row * pitch + (k0 + 8 * hh) * 2); }
__device__ __forceinline__ bf16x8v frag_perm(const LAS unsigned char* img, int row, int pitch, int k0, int hh) {
    const s16x4v lo = *(const LAS s16x4v*)(img + row * pitch + (k0 + 4 * hh) * 2), hi = *(const LAS s16x4v*)(img + row * pitch + (k0 + 8 + 4 * hh) * 2);
    return __builtin_shufflevector(lo, hi, 0, 1, 2, 3, 4, 5, 6, 7);
}
__device__ __forceinline__ f32x16 zero16() { f32x16 z;
#pragma unroll
    for (int i = 0; i < 16; ++i) z[i] = 0.f;
    return z; }
#define PACK_STEP(X, s) pack8m((X)[8 * (s)], (X)[8 * (s) + 1], (X)[8 * (s) + 2], (X)[8 * (s) + 3], (X)[8 * (s) + 4], (X)[8 * (s) + 5], (X)[8 * (s) + 6], (X)[8 * (s) + 7])
#define PACK_STEP_L(X, s) pack8((X)[8 * (s)], (X)[8 * (s) + 1], (X)[8 * (s) + 2], (X)[8 * (s) + 3], (X)[8 * (s) + 4], (X)[8 * (s) + 5], (X)[8 * (s) + 6], (X)[8 * (s) + 7])

constexpr int GA_IK = 0, GA_IQ = 17408, GA_IV = 34816, GA_SL = 67584, GA_SG = 84992;
constexpr int GA_AU = 86016, GA_AW = 95232, GA_T00 = 104448, GA_T11 = 107008, GA_L10 = 109568;
__device__ __forceinline__ const LAS unsigned char* tr_addr(const LAS unsigned char* img, int pitch, int n0, int lane) {
    return img + (8 * (lane >> 5) + ((lane & 15) >> 2)) * pitch + (n0 + 16 * ((lane >> 4) & 1) + 4 * (lane & 3)) * 2;
}
template <int PITCH> __device__ __forceinline__ bf16x8v tr_frag(const LAS unsigned char* a) {
    s16x4v lo, hi;
    asm volatile("ds_read_b64_tr_b16 %0, %2\n\tds_read_b64_tr_b16 %1, %2 offset:%3\n\ts_waitcnt lgkmcnt(0)" : "=&v"(lo), "=&v"(hi) : "v"(a), "n"(4 * PITCH) : "memory");
    return __builtin_shufflevector(lo, hi, 0, 1, 2, 3, 4, 5, 6, 7);
}
__device__ __forceinline__ void gdn_tinv(LAS unsigned char* lds, int lane) {
    LAS unsigned char* bL = lds + GA_SL; LAS unsigned char* bG = lds + GA_SG; LAS unsigned char* bA = lds + GA_AU;
    asm volatile("" : "+v"(bL), "+v"(bG), "+v"(bA));
    const int blk = lane >> 5, c = lane & 31, r = lane & 31, hh = lane >> 5;
    const LAS unsigned char* pL = bL + (32 * blk * 68 + 32 * blk) * 4;
    float x[32];
#pragma unroll
    for (int i = 0; i < 32; ++i) {
        if (i > 2) asm volatile("" : "+v"(pL) : "v"(x[i > 2 ? i - 3 : 0]));
        const LAS float* sL = (const LAS float*)pL;
        float a = (i == c) ? 1.f : 0.f, a1 = 0.f, a2 = 0.f, a3 = 0.f;
#pragma unroll
        for (int j4 = 0; j4 < (i + 3) / 4; ++j4) { const f32x4 l4 = *(const LAS f32x4*)(sL + i * 68 + 4 * j4);
            if (4 * j4 + 0 < i) a -= l4[0] * x[4 * j4 + 0]; if (4 * j4 + 1 < i) a1 -= l4[1] * x[4 * j4 + 1]; if (4 * j4 + 2 < i) a2 -= l4[2] * x[4 * j4 + 2]; if (4 * j4 + 3 < i) a3 -= l4[3] * x[4 * j4 + 3]; }
        x[i] = (a + a1) + (a2 + a3);
    }
    const LAS float* sG = (const LAS float*)bG; const float su = sG[64 + lane], sw = -su * sG[128 + lane];
    { LAS unsigned char* tI = bA + (GA_T00 - GA_AU) + blk * 2560 + c * 2; LAS unsigned char* aU = bA + (32 * blk) * 144 + lane * 2; LAS unsigned char* aW = aU + (GA_AW - GA_AU);
#pragma unroll
      for (int i = 0; i < 32; ++i) { *(LAS bf16*)(tI + i * 80) = (bf16)f2bf(x[i]); *(LAS bf16*)(aU + i * 144) = (bf16)f2bf(x[i] * su); *(LAS bf16*)(aW + i * 144) = (bf16)f2bf(x[i] * sw); } }
    LDS_WAIT();
    f32x16 P = zero16();
    { const LAS unsigned char* tb = tr_addr(bA + (GA_T00 - GA_AU), 80, 0, lane);
#pragma unroll
      for (int s2 = 0; s2 < 2; ++s2) { const bf16x8v a = frag_nat(bA + (GA_L10 - GA_AU), r, 80, 16 * s2, hh), bb = tr_frag<80>(tb + 16 * s2 * 80); P = MFMA32(a, bb, P); } }
    f32x16 Q = zero16();
#pragma unroll
    for (int s2 = 0; s2 < 2; ++s2) { const bf16x8v a = frag_perm(bA + (GA_T11 - GA_AU), r, 80, 16 * s2, hh), bb = PACK_STEP(P, s2); Q = MFMA32(a, bb, Q); }
    const float su0 = sG[64 + r], sw0 = su0 * sG[128 + r];
#pragma unroll
    for (int reg = 0; reg < 16; ++reg) { LAS unsigned char* aU = bA + (32 + crow(reg, hh)) * 144 + r * 2;
        *(LAS bf16*)aU = (bf16)f2bf(-Q[reg] * su0); *(LAS bf16*)(aU + (GA_AW - GA_AU)) = (bf16)f2bf(Q[reg] * sw0); }
}
__device__ __forceinline__ void gdn_apply(const LAS unsigned char* lds, int mat, int ct, int lane, GAS bf16* out) {
    const LAS unsigned char* bA = lds + GA_AU; asm volatile("" : "+v"(bA));
    const int r = lane & 31, hh = lane >> 5;
    const LAS unsigned char* img = bA + (mat ? GA_IK - GA_AU : GA_IV - GA_AU); const LAS unsigned char* A = bA + (mat ? GA_AW - GA_AU : 0);
    const LAS unsigned char* tb = tr_addr(img, 272, 32 * ct, lane);
    f32x16 X0 = zero16(), X1 = zero16();
    bf16x8v a0_[2], a1_[4], bb[4];
#pragma unroll
    for (int s4 = 0; s4 < 4; ++s4) { if (s4 < 2) a0_[s4] = frag_nat(A, r, 144, 16 * s4, hh); a1_[s4] = frag_nat(A, 32 + r, 144, 16 * s4, hh); }
    { s16x4v l0, h0, l1, h1, l2, h2, l3, h3;
      asm volatile("ds_read_b64_tr_b16 %0, %8\n\tds_read_b64_tr_b16 %1, %8 offset:1088\n\tds_read_b64_tr_b16 %2, %8 offset:4352\n\tds_read_b64_tr_b16 %3, %8 offset:5440\n\t"
                   "ds_read_b64_tr_b16 %4, %8 offset:8704\n\tds_read_b64_tr_b16 %5, %8 offset:9792\n\tds_read_b64_tr_b16 %6, %8 offset:13056\n\tds_read_b64_tr_b16 %7, %8 offset:14144\n\ts_waitcnt lgkmcnt(0)"
                   : "=&v"(l0), "=&v"(h0), "=&v"(l1), "=&v"(h1), "=&v"(l2), "=&v"(h2), "=&v"(l3), "=&v"(h3) : "v"(tb) : "memory");
      bb[0] = __builtin_shufflevector(l0, h0, 0, 1, 2, 3, 4, 5, 6, 7); bb[1] = __builtin_shufflevector(l1, h1, 0, 1, 2, 3, 4, 5, 6, 7);
      bb[2] = __builtin_shufflevector(l2, h2, 0, 1, 2, 3, 4, 5, 6, 7); bb[3] = __builtin_shufflevector(l3, h3, 0, 1, 2, 3, 4, 5, 6, 7); }
#pragma unroll
    for (int s4 = 0; s4 < 4; ++s4) { if (s4 < 2) X0 = MFMA32(a0_[s4], bb[s4], X0); X1 = MFMA32(a1_[s4], bb[s4], X1); }
    GAS bf16* o = out + 32 * ct + r;
#pragma unroll
    for (int reg = 0; reg < 16; ++reg) { o[crow(reg, hh) * 128] = (bf16)f2bf(X0[reg]); o[(32 + crow(reg, hh)) * 128] = (bf16)f2bf(X1[reg]); }
}
__device__ __forceinline__ void ea_gdn(const Params& p0, LAS unsigned char* lds, int ch, int je) {
    PHASE_IDS(); Params p = p0; asm volatile("" : "+s"(p.ws)); GLOBAL_PARAMS(p);
    const int n = ch & 31, h = (ch >> 5) & 7, b = ch >> 8, t0 = n * 64, r = lane & 31, hh = lane >> 5;
    const GAS bf16* Z = (const GAS bf16*)(p.ws + WS_Z); const GAS float* gates = (const GAS float*)(p.ws + WS_GATES);
    LAS float* sL = (LAS float*)(lds + GA_SL); LAS float* sG = (LAS float*)(lds + GA_SG); LAS float* sBeta = sG + 64; LAS float* sEg = sG + 128; LAS float* sLd = sG + 192;
    if (tid < 384) {
        const int cc = tid % 48, tg = tid / 48, which = cc >> 4, c8 = (cc & 15) * 8;
        const int zcol = 4096 + which * 1024 + h * 128 + c8, wcol = which * 1024 + h * 128 + c8;
        v4u zin[11];
#pragma unroll
        for (int i = 0; i < 11; ++i) { const int tpos = t0 + tg * 8 - 3 + i; zin[i] = (tpos >= 0) ? *(const GAS v4u*)(Z + ((size_t)b * T + (tpos >= 0 ? tpos : 0)) * ZE + zcol) : (v4u){0u, 0u, 0u, 0u}; }
        f32x4 wA[4], wB[4];
#pragma unroll
        for (int kk = 0; kk < 4; ++kk) { const GAS float* cw = p.conv_w + ((size_t)(je * 4 + kk)) * 3072 + wcol; wA[kk] = *(const GAS f32x4*)cw; wB[kk] = *(const GAS f32x4*)(cw + 4); }
#pragma unroll
        for (int t8 = 0; t8 < 8; ++t8) { const int tt = tg * 8 + t8; float acc[8];
#pragma unroll
            for (int i = 0; i < 8; ++i) acc[i] = 0.f;
#pragma unroll
            for (int kk = 0; kk < 4; ++kk) { const v4u zw = zin[t8 + kk];
                acc[0] += wA[kk][0] * bflo(zw.x); acc[1] += wA[kk][1] * bfhi(zw.x); acc[2] += wA[kk][2] * bflo(zw.y); acc[3] += wA[kk][3] * bfhi(zw.y);
                acc[4] += wB[kk][0] * bflo(zw.z); acc[5] += wB[kk][1] * bfhi(zw.z); acc[6] += wB[kk][2] * bflo(zw.w); acc[7] += wB[kk][3] * bfhi(zw.w); }
            float ss = 0.f;
#pragma unroll
            for (int i = 0; i < 8; ++i) { acc[i] = silu2_f(acc[i]); ss += acc[i] * acc[i]; }
            ss = row16_sum(ss);
            { const float sc = which < 2 ? __builtin_amdgcn_rsqf(ss + 1e-6f) * (which == 0 ? 0.08838834764831845f : 1.0f) : 1.0f;
                v4u w; w.x = pk2(acc[0] * sc, acc[1] * sc); w.y = pk2(acc[2] * sc, acc[3] * sc); w.z = pk2(acc[4] * sc, acc[5] * sc); w.w = pk2(acc[6] * sc, acc[7] * sc);
                *(LAS v4u*)(lds + (which == 0 ? GA_IQ : which == 1 ? GA_IK : GA_IV) + tt * 272 + c8 * 2) = w; }
        }
    }
    if (tid >= 384 && tid < 448) { const int tk = tid - 384; const size_t m = (size_t)b * T + t0 + tk; const float ba = gates[m * 64 + h], bb = gates[m * 64 + 8 + h];
        const float xx = ba + p.dt_bias[je * 8 + h]; const float sp = xx > 20.f ? xx : __logf(1.0f + __expf(xx));
        float v = -__expf(p.a_log[je * 8 + h]) * sp; sBeta[tk] = sigmoid_f(bb);
#pragma unroll
        for (int o = 1; o < 64; o <<= 1) { const float x = __shfl_up(v, o); if (tk >= o) v += x; }
        sG[tk] = v; sEg[tk] = __expf(v); }
    __syncthreads();
    { const int mat = wave >> 2, ti = (wave >> 1) & 1, tj = wave & 1;
      const LAS unsigned char* imgA = lds + (mat ? GA_IQ : GA_IK); f32x16 acc = zero16(); bf16x8v fa_[8], fb_[8];
#pragma unroll
      for (int s = 0; s < 8; ++s) { fa_[s] = frag_nat(imgA, 32 * ti + r, 272, 16 * s, hh); fb_[s] = frag_nat(lds + GA_IK, 32 * tj + r, 272, 16 * s, hh); }
      __builtin_amdgcn_sched_barrier(0);
#pragma unroll
      for (int s = 0; s < 8; ++s) acc = MFMA32(fa_[s], fb_[s], acc);
      const int sc_ = 32 * tj + r; const float gs = sG[sc_];
      GAS bf16* QKG = (GAS bf16*)(p.ws + WS_GREC) + (size_t)ch * GREC + G_QKG;
#pragma unroll
      for (int reg = 0; reg < 16; ++reg) { const int tt = 32 * ti + crow(reg, hh); const float val = acc[reg] * __expf(sG[tt] - gs);
          if (mat == 0) { const float lv = (sc_ < tt) ? sBeta[tt] * val : 0.f; sL[tt * 68 + sc_] = lv; if (ti == 1 && tj == 0) *(LAS bf16*)(lds + GA_L10 + (tt - 32) * 80 + sc_ * 2) = (bf16)f2bf(lv); }
          else QKG[tt * 64 + sc_] = (bf16)f2bf((sc_ <= tt) ? val : 0.f); } }
    __syncthreads();
    if (wave == 0) gdn_tinv(lds, lane);
    else if (wave < 4) { }
    else {
        const int ht = tid - 256; const float gend = sG[63];
        GAS bf16* QG = (GAS bf16*)(p.ws + WS_GREC) + (size_t)ch * GREC + G_QG;
#pragma unroll
        for (int k = 0; k < 4; ++k) { const int cidx = ht + 256 * k, tt = cidx >> 4, c16 = cidx & 15; const float e = sEg[tt];
            const v4u w = *(const LAS v4u*)(lds + GA_IQ + tt * 272 + c16 * 16); v4u o;
            o.x = pk2(bflo(w.x) * e, bfhi(w.x) * e); o.y = pk2(bflo(w.y) * e, bfhi(w.y) * e); o.z = pk2(bflo(w.z) * e, bfhi(w.z) * e); o.w = pk2(bflo(w.w) * e, bfhi(w.w) * e);
            *(GAS v4u*)(QG + tt * 128 + c16 * 8) = o; }
        { const int d = ht & 127, tp = ht >> 7; GAS bf16* KGT = (GAS bf16*)(p.ws + WS_GREC) + (size_t)ch * GREC + G_KGT + d * 64 + 32 * tp;
#pragma unroll
          for (int q8 = 0; q8 < 4; ++q8) { float v[8], gz_[8]; unsigned short kz_[8];
#pragma unroll
              for (int i = 0; i < 8; ++i) { const int tt = 32 * tp + 8 * q8 + i; kz_[i] = *(const LAS unsigned short*)(lds + GA_IK + tt * 272 + d * 2); gz_[i] = sG[tt]; }
              __builtin_amdgcn_sched_barrier(0);
#pragma unroll
              for (int i = 0; i < 8; ++i) v[i] = bflo((unsigned)kz_[i]) * __expf(gend - gz_[i]);
              v4u o; o.x = pk2(v[0], v[1]); o.y = pk2(v[2], v[3]); o.z = pk2(v[4], v[5]); o.w = pk2(v[6], v[7]); *(GAS v4u*)(KGT + 8 * q8) = o; } }
        if (ht == 0) ((GAS float*)(p.ws + WS_GEND))[ch] = __expf(gend);
    }
    __syncthreads();
    gdn_apply(lds, wave >> 2, wave & 3, lane, (GAS bf16*)(p.ws + WS_GREC) + (size_t)ch * GREC + (wave >> 2 ? G_NW : G_UU));
    __syncthreads();
}

constexpr int HA_IQ = 0, HA_IK0 = 17408, HA_IK1 = 26112, HA_IVT = 43520, HA_IIN = 61952, HA_TOT = 71168;
__device__ __forceinline__ void ea_hgrn(const Params& p0, LAS unsigned char* lds, int ch, int je) {
    PHASE_IDS(); Params p = p0; asm volatile("" : "+s"(p.ws)); GLOBAL_PARAMS(p);
    const int n = ch & 31, h = (ch >> 5) & 7, b = ch >> 8, t0 = n * 64, r = lane & 31, hh = lane >> 5;
    const GAS bf16* Z = (const GAS bf16*)(p.ws + WS_Z);
    LAS float* sTot = (LAS float*)(lds + HA_TOT);
    const int d = tid & 127, part = tid >> 7;
    float q[16], kk[16], v[16], bcs[16];
    { const int chn = h * 128 + d; const float lb = je ? sigmoid_f(p.hgrn_lb[1024 + chn] - p.hgrn_lb[chn]) : 0.f; float run = 0.f; bf16 zq[16], zf[16], zv[16];
#pragma unroll
      for (int i = 0; i < 16; ++i) { const size_t m = (size_t)b * T + t0 + 16 * part + i; const GAS bf16* zr = Z + m * ZE + chn; zq[i] = zr[0]; zf[i] = zr[1024]; zv[i] = zr[2048]; }
      __builtin_amdgcn_sched_barrier(0);
#pragma unroll
      for (int i = 0; i < 16; ++i) { q[i] = bflo((unsigned)zq[i]); const float fl = bflo((unsigned)zf[i]); v[i] = bflo((unsigned)zv[i]);
          const float f = lb + (1.0f - lb) * sigmoid_f(fl); kk[i] = 1.0f - f; run += __logf(f); bcs[i] = run; }
      sTot[part * 128 + d] = run; }
    __syncthreads();
    const float tot0 = sTot[d], tot1 = sTot[128 + d], tot2 = sTot[256 + d], tot3 = sTot[384 + d];
    const float off = (part > 0 ? tot0 : 0.f) + (part > 1 ? tot1 : 0.f) + (part > 2 ? tot2 : 0.f);
    const float b31 = tot0 + tot1, bend = (tot0 + tot1) + (tot2 + tot3), ref = (part >= 2) ? b31 : 0.f;
    {
        GAS bf16* QH = (GAS bf16*)(p.ws + WS_HREC) + (size_t)ch * HREC + H_QH + d; float kh[16];
#pragma unroll
        for (int i = 0; i < 16; ++i) { const int tt = 16 * part + i; const float bt = bcs[i] + off;
            *(LAS unsigned short*)(lds + HA_IQ + tt * 272 + d * 2) = (unsigned short)f2bf(q[i] * __expf(bt - ref));
            if (part < 2) *(LAS unsigned short*)(lds + HA_IK0 + tt * 272 + d * 2) = (unsigned short)f2bf(kk[i] * __expf(fminf(-bt, 80.f)));
            *(LAS unsigned short*)(lds + HA_IK1 + tt * 272 + d * 2) = (unsigned short)f2bf(kk[i] * __expf(fminf(b31 - bt, 80.f)));
            QH[tt * 128] = (bf16)f2bf(q[i] * __expf(bt)); kh[i] = kk[i] * __expf(bend - bt); }
        v4u k0, k1, v0, v1;
        k0.x = pk2(kh[0], kh[1]); k0.y = pk2(kh[2], kh[3]); k0.z = pk2(kh[4], kh[5]); k0.w = pk2(kh[6], kh[7]); k1.x = pk2(kh[8], kh[9]); k1.y = pk2(kh[10], kh[11]); k1.z = pk2(kh[12], kh[13]); k1.w = pk2(kh[14], kh[15]);
        v0.x = pk2(v[0], v[1]); v0.y = pk2(v[2], v[3]); v0.z = pk2(v[4], v[5]); v0.w = pk2(v[6], v[7]); v1.x = pk2(v[8], v[9]); v1.y = pk2(v[10], v[11]); v1.z = pk2(v[12], v[13]); v1.w = pk2(v[14], v[15]);
        GAS bf16* KHT = (GAS bf16*)(p.ws + WS_HREC) + (size_t)ch * HREC + H_KHT + d * 64 + 16 * part; *(GAS v4u*)KHT = k0; *(GAS v4u*)(KHT + 8) = k1;
        GAS bf16* VHT = (GAS bf16*)(p.ws + WS_HREC) + (size_t)ch * HREC + H_VHT + d * 64 + 16 * part; *(GAS v4u*)VHT = v0; *(GAS v4u*)(VHT + 8) = v1;
        *(LAS v4u*)(lds + HA_IVT + d * 144 + 32 * part) = v0; *(LAS v4u*)(lds + HA_IVT + d * 144 + 32 * part + 16) = v1;
        if (part == 0) ((GAS float*)((GAS bf16*)(p.ws + WS_HREC) + (size_t)ch * HREC + H_DE))[d] = __expf(bend);
    }
    __syncthreads();
    if (wave < 3) { const int ti = wave ? 1 : 0, kr0 = (wave == 2) ? 32 : 0; const LAS unsigned char* imgK = lds + (wave ? HA_IK1 : HA_IK0); f32x16 acc = zero16(); bf16x8v fa_[8], fb_[8];
#pragma unroll
        for (int s = 0; s < 8; ++s) { fa_[s] = frag_nat(lds + HA_IQ, 32 * ti + r, 272, 16 * s, hh); fb_[s] = frag_nat(imgK, kr0 + r, 272, 16 * s, hh); }
        __builtin_amdgcn_sched_barrier(0);
#pragma unroll
        for (int s = 0; s < 8; ++s) acc = MFMA32(fa_[s], fb_[s], acc);
        const int sc_ = kr0 + r;
#pragma unroll
        for (int reg = 0; reg < 16; ++reg) { const int tt = 32 * ti + crow(reg, hh); *(LAS unsigned short*)(lds + HA_IIN + tt * 144 + sc_ * 2) = (unsigned short)f2bf((sc_ <= tt) ? acc[reg] : 0.f); } }
    __syncthreads();
    { const int mt = wave >> 2, nt = wave & 3; f32x16 acc = zero16(); const int nks = mt ? 4 : 2;
      for (int ks = 0; ks < nks; ++ks) { const bf16x8v a = frag_nat(lds + HA_IIN, 32 * mt + r, 144, 16 * ks, hh), bb = frag_nat(lds + HA_IVT, 32 * nt + r, 144, 16 * ks, hh); acc = MFMA32(a, bb, acc); }
      GAS bf16* OI = (GAS bf16*)(p.ws + WS_HREC) + (size_t)ch * HREC + H_OI + 32 * nt + r;
#pragma unroll
      for (int reg = 0; reg < 16; ++reg) OI[(32 * mt + crow(reg, hh)) * 128] = (bf16)f2bf(acc[reg]); }
    __syncthreads();
}

constexpr int GB_NW = 0, GB_QG = 17408, GB_KGT = 34816, GB_QK = 52224, GB_UU = 60928, GB_BUF = 65536;
constexpr int HB_QH = 0, HB_KHT = 17408, HB_VT = 35840, HB_OI = 40448, HB_DE = 49664, HB_BUF = 50176;
__device__ __forceinline__ void gb_chunk(const Params& p, int ch, int sl, int c, const GAS v4u*& src, int& dst, bool& two64) {
    const GAS v4u* rec = (const GAS v4u*)((const GAS bf16*)(p.ws + WS_GREC) + (size_t)ch * GREC);
    if (c < 3584) { const int k = c - 2048; src = rec + c; two64 = c >= 2048; dst = two64 ? GB_KGT + (k >> 3) * 136 + (k & 7) * 16 : (c >> 4) * 272 + (c & 15) * 16; }
    else { const int k = c - 3584; src = rec + (G_UU / 8 + sl * 4) + (k >> 2) * 16 + (k & 3); dst = GB_UU + (k >> 2) * 72 + (k & 3) * 16; two64 = true; }
}
__device__ __forceinline__ void hb_chunk(const Params& p, int ch, int sl, int c, const GAS v4u*& src, int& dst) {
    const GAS v4u* rec = (const GAS v4u*)((const GAS bf16*)(p.ws + WS_HREC) + (size_t)ch * HREC);
    int off;
    if (c < 2048) { const int k = c - 1024; off = c; dst = c < 1024 ? (c >> 4) * 272 + (c & 15) * 16 : HB_KHT + (k >> 3) * 144 + (k & 7) * 16; }
    else if (c < 2304) { const int k = c - 2048; off = H_VHT / 8 + sl * 256 + k; dst = HB_VT + (k >> 3) * 144 + (k & 7) * 16; }
    else if (c < 2560) { const int k = c - 2304; off = H_OI / 8 + sl * 4 + (k >> 2) * 16 + (k & 3); dst = HB_OI + (k >> 2) * 80 + (k & 3) * 16; }
    else { const int k = c - 2560; off = H_DE / 8 + k; dst = HB_DE + k * 16; }
    src = rec + off;
}
template <int MIXER> struct EbRegs { v4u r[MIXER ? 9 : 6]; };
template <int MIXER> __device__ __forceinline__ void eb_load(const Params& p, EbRegs<MIXER>& R, int ch, int sl, int ht, int nth) {
    constexpr int NCH = MIXER ? 3840 : 2592, NR = MIXER ? 9 : 6;
    asm volatile("" : "+v"(ht));
    __builtin_assume(ht >= 0 && ht < nth);
#pragma unroll
    for (int i = 0; i < NR; ++i) { const int c = ht + nth * i; if (c < NCH) { const GAS v4u* src; int dst; bool t64 = false; if (MIXER) gb_chunk(p, ch, sl, c, src, dst, t64); else hb_chunk(p, ch, sl, c, src, dst); R.r[i] = *src; } }
}
template <int MIXER> __device__ __forceinline__ void eb_store(const Params& p, const EbRegs<MIXER>& R, LAS unsigned char* buf, int ch, int sl, int ht, int nth) {
    constexpr int NCH = MIXER ? 3840 : 2592, NR = MIXER ? 9 : 6;
    asm volatile("" : "+v"(ht));
    __builtin_assume(ht >= 0 && ht < nth);
#pragma unroll
    for (int i = 0; i < NR; ++i) { const int c = ht + nth * i; if (c < NCH) { const GAS v4u* src; int dst; bool t64 = false; if (MIXER) gb_chunk(p, ch, sl, c, src, dst, t64); else hb_chunk(p, ch, sl, c, src, dst);
        if (t64) { v2u a, b2; a.x = R.r[i].x; a.y = R.r[i].y; b2.x = R.r[i].z; b2.y = R.r[i].w; *(LAS v2u*)(buf + dst) = a; *(LAS v2u*)(buf + dst + 8) = b2; }
        else *(LAS v4u*)(buf + dst) = R.r[i]; } }
}
#define CHAIN8(ACC, FR, B0_, B1_, B2_, B3_, B4_, B5_, B6_, B7_) do { \
    const bf16x8v _a0 = FR(0), _a1 = FR(1), _a2 = FR(2), _a3 = FR(3); __builtin_amdgcn_sched_barrier(0); \
    const bf16x8v _a4 = FR(4), _a5 = FR(5), _a6 = FR(6), _a7 = FR(7); \
    ACC = MFMA32(_a0, B0_, ACC); ACC = MFMA32(_a1, B1_, ACC); ACC = MFMA32(_a2, B2_, ACC); ACC = MFMA32(_a3, B3_, ACC); __builtin_amdgcn_sched_barrier(0); \
    ACC = MFMA32(_a4, B4_, ACC); ACC = MFMA32(_a5, B5_, ACC); ACC = MFMA32(_a6, B6_, ACC); ACC = MFMA32(_a7, B7_, ACC); } while (0)
template <int MIXER> __device__ __forceinline__ void eb_scan(const Params& p0, LAS unsigned char* lds, int bh, int sl) {
    PHASE_IDS(); Params p = p0; asm volatile("" : "+s"(p.ws)); GLOBAL_PARAMS(p);
    constexpr int BUF = MIXER ? GB_BUF : HB_BUF;
    const int r = lane & 31, hh = lane >> 5, b = bh >> 3, h = bh & 7;
    f32x16 S[4];
#pragma unroll
    for (int kt = 0; kt < 4; ++kt) S[kt] = zero16();
    EbRegs<MIXER> R;
    eb_load<MIXER>(p, R, bh * 32, sl, tid, 512); eb_store<MIXER>(p, R, lds, bh * 32, sl, tid, 512);
    if (wave != 0) eb_load<MIXER>(p, R, bh * 32 + 1, sl, tid - 64, 448);
    __syncthreads();
    constexpr int OST = 131072, OSTB = 5120;
    GAS bf16* OA = (GAS bf16*)(p.ws + WS_OA) + ((size_t)b * T) * 2048 + MIXER * 1024 + h * 128 + sl * 32;
#pragma unroll 1
    for (int n = 0; n < 32; ++n) {
        const int ch = bh * 32 + n; const LAS unsigned char* B = lds + (n & 1) * BUF;
        if (wave != 0) {
            if (n + 1 < 32) eb_store<MIXER>(p, R, lds + ((n + 1) & 1) * BUF, ch + 1, sl, tid - 64, 448);
            if (n + 2 < 32) eb_load<MIXER>(p, R, ch + 2, sl, tid - 64, 448);
            if (n > 0 && tid - 64 < 256) { const int ht = tid - 64, row = ht >> 2, c4 = ht & 3;
                *(GAS v4u*)(OA + (size_t)((n - 1) * 64 + row) * 2048 + c4 * 8) = *(const LAS v4u*)(lds + OST + ((n - 1) & 1) * OSTB + row * 80 + c4 * 16); } }
        else {
            bf16x8v sp[4][2];
#pragma unroll
            for (int kt = 0; kt < 4; ++kt) { sp[kt][0] = kt ? PACK_STEP_L(S[kt], 0) : PACK_STEP(S[kt], 0); sp[kt][1] = PACK_STEP_L(S[kt], 1); }
            LAS unsigned char* orow = lds + OST + (n & 1) * OSTB + r * 2;
            if (MIXER) {
                const float eg = ((const GAS float*)(p.ws + WS_GEND))[ch];
                f32x16 VN[2];
                { unsigned short uu_[2][16];
#pragma unroll
                  for (int mt = 0; mt < 2; ++mt)
#pragma unroll
                    for (int reg = 0; reg < 16; ++reg) uu_[mt][reg] = *(const LAS unsigned short*)(B + GB_UU + (32 * mt + crow(reg, hh)) * 72 + r * 2);
                  __builtin_amdgcn_sched_barrier(0);
#pragma unroll
                  for (int mt = 0; mt < 2; ++mt)
#pragma unroll
                    for (int reg = 0; reg < 16; ++reg) VN[mt][reg] = bflo((unsigned)uu_[mt][reg]); }
#define FR_NW0(i) frag_perm(B + GB_NW, r, 272, 16 * (i), hh)
#define FR_NW1(i) frag_perm(B + GB_NW, 32 + r, 272, 16 * (i), hh)
                CHAIN8(VN[0], FR_NW0, sp[0][0], sp[0][1], sp[1][0], sp[1][1], sp[2][0], sp[2][1], sp[3][0], sp[3][1]);
                CHAIN8(VN[1], FR_NW1, sp[0][0], sp[0][1], sp[1][0], sp[1][1], sp[2][0], sp[2][1], sp[3][0], sp[3][1]);
                bf16x8v vp[2][2];
#pragma unroll
                for (int mt = 1; mt >= 0; --mt) { vp[mt][0] = mt ? PACK_STEP(VN[mt], 0) : PACK_STEP_L(VN[mt], 0); vp[mt][1] = PACK_STEP_L(VN[mt], 1); }
                bf16x8v qkf[2][4];
#pragma unroll
                for (int mt = 0; mt < 2; ++mt)
#pragma unroll
                    for (int m2 = 0; m2 <= mt; ++m2)
#pragma unroll
                        for (int s = 0; s < 2; ++s) qkf[mt][2 * m2 + s] = frag_perm(B + GB_QK, 32 * mt + r, 136, 32 * m2 + 16 * s, hh);
                __builtin_amdgcn_sched_barrier(0);
#pragma unroll
                for (int mt = 0; mt < 2; ++mt) { f32x16 O = zero16();
#define FR_QG(i) frag_perm(B + GB_QG, 32 * mt + r, 272, 16 * (i), hh)
                    CHAIN8(O, FR_QG, sp[0][0], sp[0][1], sp[1][0], sp[1][1], sp[2][0], sp[2][1], sp[3][0], sp[3][1]);
#pragma unroll
                    for (int m2 = 0; m2 <= mt; ++m2)
#pragma unroll
                        for (int s = 0; s < 2; ++s) O = MFMA32(qkf[mt][2 * m2 + s], vp[m2][s], O);
                    __builtin_amdgcn_sched_barrier(0);
                    const bf16x8v oq0 = PACK_STEP(O, 0), oq1 = PACK_STEP_L(O, 1);
#pragma unroll
                    for (int reg = 0; reg < 16; ++reg) *(LAS bf16*)(orow + (32 * mt + crow(reg, hh)) * 80) = (bf16)(reg < 8 ? oq0[reg & 7] : oq1[reg & 7]); }
#define LD_KGT(F, kt_) do { F[0] = frag_perm(B + GB_KGT, 32 * (kt_) + r, 136, 0, hh); F[1] = frag_perm(B + GB_KGT, 32 * (kt_) + r, 136, 16, hh); F[2] = frag_perm(B + GB_KGT, 32 * (kt_) + r, 136, 32, hh); F[3] = frag_perm(B + GB_KGT, 32 * (kt_) + r, 136, 48, hh); } while (0)
#define UP_S(F, kt_) do { _Pragma("unroll") for (int reg = 0; reg < 16; ++reg) S[kt_][reg] *= eg; \
                    S[kt_] = MFMA32(F[0], vp[0][0], S[kt_]); S[kt_] = MFMA32(F[1], vp[0][1], S[kt_]); S[kt_] = MFMA32(F[2], vp[1][0], S[kt_]); S[kt_] = MFMA32(F[3], vp[1][1], S[kt_]); } while (0)
                { bf16x8v fa[4], fb[4];
                  LD_KGT(fa, 0); __builtin_amdgcn_sched_barrier(0);
                  LD_KGT(fb, 1); UP_S(fa, 0); __builtin_amdgcn_sched_barrier(0);
                  LD_KGT(fa, 2); UP_S(fb, 1); __builtin_amdgcn_sched_barrier(0);
                  LD_KGT(fb, 3); UP_S(fa, 2); __builtin_amdgcn_sched_barrier(0);
                  UP_S(fb, 3); }
            } else {
#pragma unroll
                for (int mt = 0; mt < 2; ++mt) { f32x16 O; unsigned short oi_[16];
#pragma unroll
                    for (int reg = 0; reg < 16; ++reg) oi_[reg] = *(const LAS unsigned short*)(B + HB_OI + (32 * mt + crow(reg, hh)) * 80 + r * 2);
                    __builtin_amdgcn_sched_barrier(0);
#pragma unroll
                    for (int reg = 0; reg < 16; ++reg) O[reg] = bflo((unsigned)oi_[reg]);
#define FR_QH(i) frag_perm(B + HB_QH, 32 * mt + r, 272, 16 * (i), hh)
                    CHAIN8(O, FR_QH, sp[0][0], sp[0][1], sp[1][0], sp[1][1], sp[2][0], sp[2][1], sp[3][0], sp[3][1]);
                    __builtin_amdgcn_sched_barrier(0);
                    const bf16x8v oq0 = PACK_STEP(O, 0), oq1 = PACK_STEP_L(O, 1);
#pragma unroll
                    for (int reg = 0; reg < 16; ++reg) *(LAS bf16*)(orow + (32 * mt + crow(reg, hh)) * 80) = (bf16)(reg < 8 ? oq0[reg & 7] : oq1[reg & 7]); }
                { bf16x8v vb[4], fa[4], fb[4];
#pragma unroll
                  for (int ks = 0; ks < 4; ++ks) vb[ks] = frag_nat(B + HB_VT, r, 144, 16 * ks, hh);
#define LD_KHT(F, kt_) do { F[0] = frag_nat(B + HB_KHT, 32 * (kt_) + r, 144, 0, hh); F[1] = frag_nat(B + HB_KHT, 32 * (kt_) + r, 144, 16, hh); F[2] = frag_nat(B + HB_KHT, 32 * (kt_) + r, 144, 32, hh); F[3] = frag_nat(B + HB_KHT, 32 * (kt_) + r, 144, 48, hh); } while (0)
#define UP_SH(F, kt_) do { _Pragma("unroll") for (int q4 = 0; q4 < 4; ++q4) { const f32x4 de = *(const LAS f32x4*)(B + HB_DE + (32 * (kt_) + 8 * q4 + 4 * hh) * 4); \
                        S[kt_][4 * q4] *= de[0]; S[kt_][4 * q4 + 1] *= de[1]; S[kt_][4 * q4 + 2] *= de[2]; S[kt_][4 * q4 + 3] *= de[3]; } \
                    S[kt_] = MFMA32(F[0], vb[0], S[kt_]); S[kt_] = MFMA32(F[1], vb[1], S[kt_]); S[kt_] = MFMA32(F[2], vb[2], S[kt_]); S[kt_] = MFMA32(F[3], vb[3], S[kt_]); } while (0)
                  LD_KHT(fa, 0); __builtin_amdgcn_sched_barrier(0);
                  LD_KHT(fb, 1); UP_SH(fa, 0); __builtin_amdgcn_sched_barrier(0);
                  LD_KHT(fa, 2); UP_SH(fb, 1); __builtin_amdgcn_sched_barrier(0);
                  LD_KHT(fb, 3); UP_SH(fa, 2); __builtin_amdgcn_sched_barrier(0);
                  UP_SH(fb, 3); }
            }
        }
        __syncthreads();
    }
    if (wave != 0 && tid - 64 < 256) { const int ht = tid - 64, row = ht >> 2, c4 = ht & 3;
        *(GAS v4u*)(OA + (size_t)(31 * 64 + row) * 2048 + c4 * 8) = *(const LAS v4u*)(lds + OST + OSTB + row * 80 + c4 * 16); }
    __syncthreads();
}
__device__ __forceinline__ void ec_phase(const Params& p0, int je) {
    PHASE_IDS(); Params p = p0; asm volatile("" : "+s"(p.ws)); GLOBAL_PARAMS(p);     const int gw = blockIdx.x * NWAVES + wave, NGW = gridDim.x * NWAVES;
    const GAS bf16* Z = (const GAS bf16*)(p.ws + WS_Z); const GAS bf16* OA = (const GAS bf16*)(p.ws + WS_OA); GAS bf16* OMIX = (GAS bf16*)(p.ws + WS_OMIX);
    const int sub = lane >> 4, e8 = (lane & 15) * 8;
    const int item0 = gw * 4 + sub, hs = item0 & 15, mixer = hs >> 3, h = hs & 7;
    const GAS float* gn = (mixer ? p.gdn_g : p.hgrn_g) + je * 128 + e8; const f32x4 ga = *(const GAS f32x4*)gn, gb = *(const GAS f32x4*)(gn + 4);
    for (int itb = item0; itb < M * 16; itb += NGW * 16) {
        v4u ow_[4], gz_[4];
#pragma unroll
        for (int u = 0; u < 4; ++u) { const int item = itb + u * NGW * 4; const size_t m = (size_t)((item < M * 16 ? item : item0) >> 4);
            ow_[u] = *(const GAS v4u*)(OA + m * 2048 + hs * 128 + e8); gz_[u] = *(const GAS v4u*)(Z + m * ZE + (mixer ? 7168 : 3072) + h * 128 + e8); }
        __builtin_amdgcn_sched_barrier(0);
#pragma unroll
        for (int u = 0; u < 4; ++u) { const int item = itb + u * NGW * 4; const size_t m = (size_t)(item >> 4); const v4u ow = ow_[u], gz = gz_[u];
            const f32x4 oa = (f32x4){bflo(ow.x), bfhi(ow.x), bflo(ow.y), bfhi(ow.y)}, ob = (f32x4){bflo(ow.z), bfhi(ow.z), bflo(ow.w), bfhi(ow.w)};
            const float ss = row16_sum((oa[0] * oa[0] + oa[1] * oa[1]) + (oa[2] * oa[2] + oa[3] * oa[3]) + (ob[0] * ob[0] + ob[1] * ob[1]) + (ob[2] * ob[2] + ob[3] * ob[3]));
            const float rstd = __builtin_amdgcn_rsqf(ss * (1.0f / 128.0f) + EPS);
            v4u o; o.x = pk2(oa[0] * rstd * ga[0] * silu2_f(bflo(gz.x)), oa[1] * rstd * ga[1] * silu2_f(bfhi(gz.x))); o.y = pk2(oa[2] * rstd * ga[2] * silu2_f(bflo(gz.y)), oa[3] * rstd * ga[3] * silu2_f(bfhi(gz.y)));
            o.z = pk2(ob[0] * rstd * gb[0] * silu2_f(bflo(gz.z)), ob[1] * rstd * gb[1] * silu2_f(bfhi(gz.z))); o.w = pk2(ob[2] * rstd * gb[2] * silu2_f(bflo(gz.w)), ob[3] * rstd * gb[3] * silu2_f(bfhi(gz.w)));
            if (item < M * 16) *(GAS v4u*)(OMIX + m * D + hs * 128 + e8) = o; }
    }
}

constexpr size_t WS_W1T = 972 * MiB, WS_W2T = 976 * MiB, WS_WXT = 977 * MiB;
typedef short bf16x8g __attribute__((ext_vector_type(8)));
#define MFMA16(a, b, c) __builtin_amdgcn_mfma_f32_16x16x32_bf16((a), (b), (c), 0, 0, 0)
constexpr int OC_RED = 0, OC_HID = 65536;
__device__ __forceinline__ void ocmp_fast(const Params& p0, LAS unsigned char* lds, int unit, int jo) {
    PHASE_IDS(); Params p = p0; asm volatile("" : "+s"(p.ws)); GLOBAL_PARAMS(p);
    const int kv = unit >> 7, b = (unit >> 5) & 3, g = (unit >> 3) & 3, jb = unit & 7, r16 = lane & 15, q4 = lane >> 4;
    const GAS bf16* Z = (const GAS bf16*)(p.ws + WS_Z); GAS bf16* CMP = (GAS bf16*)(p.ws + WS_CMP);
    const int j = 16 * jb + r16, jc = j < 126 ? j : 126;
    const GAS bf16* zbase = Z + ((size_t)b * T + 16 * jc) * ZO + 2048 + kv * 512 + g * 128 + 8 * q4;
    const GAS bf16* w1t = (const GAS bf16*)(p.ws + WS_W1T) + (size_t)(jo * 2 + kv) * 128 * 4096 + (size_t)r16 * 4096 + 8 * q4;
    const GAS float* pos = p.cmp_pos + (size_t)(jo * 2 + kv) * 32 * 128 + 8 * q4;
    f32x4 acc[8];
#pragma unroll
    for (int nt = 0; nt < 8; ++nt) acc[nt] = (f32x4){0.f, 0.f, 0.f, 0.f};
    v4u zw[2][2]; f32x4 pa[2][2], pb[2][2]; bf16x8g bb[2][2][8];
#define OC_LOAD_(kb_, bu) { _Pragma("unroll") for (int u = 0; u < 2; ++u) { const int kg = wave * 16 + 2 * (kb_) + u, l = kg >> 2, d0 = (kg & 3) * 32; \
        zw[bu][u] = *(const GAS v4u*)(zbase + (size_t)l * ZO + d0); pa[bu][u] = *(const GAS f32x4*)(pos + l * 128 + d0); pb[bu][u] = *(const GAS f32x4*)(pos + l * 128 + d0 + 4); \
        _Pragma("unroll") for (int nt = 0; nt < 8; ++nt) bb[bu][u][nt] = *(const GAS bf16x8g*)(w1t + (size_t)nt * 16 * 4096 + kg * 32); } }
    OC_LOAD_(0, 0)
#pragma unroll
    for (int kb = 0; kb < 8; ++kb) {
        if (kb < 7) { if (kb & 1) OC_LOAD_(kb + 1, 0) else OC_LOAD_(kb + 1, 1) }
        __builtin_amdgcn_sched_barrier(0);
#pragma unroll
        for (int u = 0; u < 2; ++u) { const f32x4 p0 = pa[kb & 1][u], p1 = pb[kb & 1][u]; const v4u z = zw[kb & 1][u];
            v4u aw; aw.x = pk2s(bflo(z.x) + p0[0], bfhi(z.x) + p0[1]); aw.y = pk2s(bflo(z.y) + p0[2], bfhi(z.y) + p0[3]); aw.z = pk2s(bflo(z.z) + p1[0], bfhi(z.z) + p1[1]); aw.w = pk2s(bflo(z.w) + p1[2], bfhi(z.w) + p1[3]);
            const bf16x8g a = __builtin_bit_cast(bf16x8g, aw);
#pragma unroll
            for (int nt = 0; nt < 8; ++nt) acc[nt] = MFMA16(a, bb[kb & 1][u][nt], acc[nt]); }
        __builtin_amdgcn_sched_barrier(0);
    }
#undef OC_LOAD_
    LAS float* red = (LAS float*)(lds + OC_RED) + wave * 2048;
#pragma unroll
    for (int nt = 0; nt < 8; ++nt)
#pragma unroll
        for (int reg = 0; reg < 4; ++reg) red[(q4 * 4 + reg) * 128 + 16 * nt + r16] = acc[nt][reg];
    __syncthreads();
    { const int row = tid >> 5, c4 = (tid & 31) * 4; f32x4 s = (f32x4){0.f, 0.f, 0.f, 0.f};
#pragma unroll
      for (int w = 0; w < 8; ++w) s = s + *(const LAS f32x4*)(lds + OC_RED + (w * 2048 + row * 128 + c4) * 4);
      v2u hw; hw.x = pk2(silu2_f(s[0]), silu2_f(s[1])); hw.y = pk2(silu2_f(s[2]), silu2_f(s[3]));
      *(LAS v2u*)(lds + OC_HID + row * 272 + c4 * 2) = hw; }
    __syncthreads();
    { const GAS bf16* w2t = (const GAS bf16*)(p.ws + WS_W2T) + (size_t)(jo * 2 + kv) * 128 * 128 + (size_t)(16 * wave + r16) * 128 + 8 * q4;
      f32x4 o = (f32x4){0.f, 0.f, 0.f, 0.f};
#pragma unroll
      for (int ks = 0; ks < 4; ++ks) { const bf16x8g a = *(const LAS bf16x8g*)(lds + OC_HID + r16 * 272 + (32 * ks + 8 * q4) * 2); const bf16x8g bb = *(const GAS bf16x8g*)(w2t + 32 * ks); o = MFMA16(a, bb, o); }
#pragma unroll
      for (int reg = 0; reg < 4; ++reg) { const int jr = 16 * jb + q4 * 4 + reg;
          CMP[((size_t)((kv * 4 + b) * 4 + g) * 128 + jr) * 128 + 16 * wave + r16] = (jr < 127) ? (bf16)f2bf(o[reg]) : (bf16)0; } }
    __syncthreads();
}

template <int NT> __device__ __forceinline__ void gate_gemm(const GAS bf16* U, const GAS bf16* wxt, LAS float* red, int tile, int kq, int lane) {
    const int r16 = lane & 15, q4 = lane >> 4;
    const GAS bf16* arow = U + (size_t)(tile * 16 + r16) * D + kq * 512 + 8 * q4; const GAS bf16* brow = wxt + (size_t)r16 * D + kq * 512 + 8 * q4;
    f32x4 acc[NT];
#pragma unroll
    for (int nt = 0; nt < NT; ++nt) acc[nt] = (f32x4){0.f, 0.f, 0.f, 0.f};
    constexpr int KB = NT == 1 ? 8 : 4;
    bf16x8g fa[2][KB], fb[2][KB][NT];
#define GG_LOAD_(bt, bu) { _Pragma("unroll") for (int k = 0; k < KB; ++k) { fa[bu][k] = *(const GAS bf16x8g*)(arow + 32 * ((bt) * KB + k)); _Pragma("unroll") for (int nt = 0; nt < NT; ++nt) fb[bu][k][nt] = *(const GAS bf16x8g*)(brow + (size_t)nt * 16 * D + 32 * ((bt) * KB + k)); } }
    GG_LOAD_(0, 0)
#pragma unroll
    for (int bt = 0; bt < 16 / KB; ++bt) {
        if (bt + 1 < 16 / KB) { if (bt & 1) GG_LOAD_(bt + 1, 0) else GG_LOAD_(bt + 1, 1) }
        __builtin_amdgcn_sched_barrier(0);
#pragma unroll
        for (int k = 0; k < KB; ++k)
#pragma unroll
            for (int nt = 0; nt < NT; ++nt) acc[nt] = MFMA16(fa[bt & 1][k], fb[bt & 1][k][nt], acc[nt]);
        __builtin_amdgcn_sched_barrier(0);
    }
#undef GG_LOAD_
#pragma unroll
    for (int nt = 0; nt < NT; ++nt)
#pragma unroll
        for (int reg = 0; reg < 4; ++reg) red[(q4 * 4 + reg) * 48 + 16 * nt + r16] = acc[nt][reg];
}
__device__ __forceinline__ void gate_phase(const Params& p0, LAS unsigned char* lds, int odd, int j, int first, int step) {
    PHASE_IDS(); Params p = p0; asm volatile("" : "+s"(p.ws)); GLOBAL_PARAMS(p);
    const GAS bf16* U = (const GAS bf16*)(p.ws + WS_U); GAS float* gates = (GAS float*)(p.ws + WS_GATES);
    const int tsel = wave >> 2, kq = wave & 3, ncol = odd ? 48 : 16;
    if (first < 0) return;
    for (int t2 = first; t2 < 256; t2 += step) {
        const int tile = 2 * t2 + tsel; LAS float* red = (LAS float*)lds + wave * 768;
        if (odd) gate_gemm<3>(U, (const GAS bf16*)(p.ws + WS_WXT) + 2 * 16 * D + (size_t)j * 48 * D, red, tile, kq, lane);
        else gate_gemm<1>(U, (const GAS bf16*)(p.ws + WS_WXT) + (size_t)j * 16 * D, red, tile, kq, lane);
        __syncthreads();
        for (int idx = tid; idx < 2 * 16 * ncol; idx += NWAVES * 64) { const int ts = idx / (16 * ncol), rem = idx % (16 * ncol), row = rem / ncol, col = rem % ncol;
            const LAS float* rb = (const LAS float*)lds + (ts * 4) * 768 + row * 48 + col;
            gates[(size_t)((2 * t2 + ts) * 16 + row) * 64 + col] = (rb[0] + rb[768]) + (rb[2 * 768] + rb[3 * 768]); }
        __syncthreads();
    }
}
__device__ __forceinline__ void tr_cols(const GAS float* W, int ldw, int col0, int ncols, GAS bf16* WT, int gtid, int ngt, const GAS float* gk) {
    for (int it = gtid; it < ncols * 256; it += ngt) { const int n = it % ncols, k8 = (it / ncols) * 8; const GAS float* s = W + (size_t)k8 * ldw + col0 + n;
        const GAS float* gq = gk + k8;
        v4u o; o.x = pk2(s[0] * gq[0], s[(size_t)ldw] * gq[1]); o.y = pk2(s[(size_t)2 * ldw] * gq[2], s[(size_t)3 * ldw] * gq[3]); o.z = pk2(s[(size_t)4 * ldw] * gq[4], s[(size_t)5 * ldw] * gq[5]); o.w = pk2(s[(size_t)6 * ldw] * gq[6], s[(size_t)7 * ldw] * gq[7]);
        *(GAS v4u*)(WT + (size_t)n * D + k8) = o; }
}
__device__ __forceinline__ void p0_extra(const Params& p0, LAS unsigned char* lds) {
    PHASE_IDS(); Params p = p0; asm volatile("" : "+s"(p.ws)); GLOBAL_PARAMS(p);     const int gw = blockIdx.x * NWAVES + wave, NGW = gridDim.x * NWAVES;
    LAS float* scr = (LAS float*)(lds + wave * 16384);
    for (int idx = 0; idx < 4; ++idx) {
        tr_matrix(p.cmp_w1 + (size_t)idx * 4096 * 128, 128, 4096, 128, (GAS bf16*)(p.ws + WS_W1T) + (size_t)idx * 128 * 4096, 0, scr, gw, NGW, lane);
        tr_matrix(p.cmp_w2 + (size_t)idx * 128 * 128, 128, 128, 128, (GAS bf16*)(p.ws + WS_W2T) + (size_t)idx * 128 * 128, 0, scr, gw, NGW, lane);
    }
    const int gtid = blockIdx.x * (NWAVES * 64) + tid, ngt = gridDim.x * NWAVES * 64;
    for (int j = 0; j < 2; ++j) {
        tr_cols(p.ab_w_in + (size_t)j * D * EVEN_IN, EVEN_IN, ZE, 16, (GAS bf16*)(p.ws + WS_WXT) + (size_t)j * 16 * D, gtid, ngt, p.norm_g + (size_t)((2 * j) * 4 + 0) * D);
        tr_cols(p.nsa_w_in + (size_t)j * D * ODD_IN, ODD_IN, ZO, 48, (GAS bf16*)(p.ws + WS_WXT) + 2 * 16 * D + (size_t)j * 48 * D, gtid, ngt, p.norm_g + (size_t)((2 * j + 1) * 4 + 0) * D);
    }
}

__global__ void __launch_bounds__(NWAVES * 64, 2) fwd(Params p) {
    extern __shared__ __attribute__((aligned(16))) unsigned char lds_raw[];
    LAS unsigned char* lds = (LAS unsigned char*)lds_raw;
    const int G = gridDim.x, bx = blockIdx.x;
    volatile LAS unsigned* MISC = (volatile LAS unsigned*)(lds + MISC_OFF);
    for (int u = threadIdx.x; u < (LDS_BYTES - LDSCTL_OFF) / 4; u += NWAVES * 64) ((LAS unsigned*)(lds + LDSCTL_OFF))[u] = 0u;
    __syncthreads();
    unsigned* ctl = (unsigned*)(p.ws + WS_CTL);
    XcdBarrier bar; bar.bar = ctl + CW_BAR; bar.x = 0; bar.st = nullptr;
    if (!MK_PER_PHASE) bar = xcd_barrier_post(ctl + CW_BAR, MISC + 8);
#ifndef REPEAT_MASK
#define REPEAT_MASK 0
#endif
    const int lo = MK_PER_PHASE ? p.ph_lo : 0, hi = MK_PER_PHASE ? p.ph_hi : N_PHASES;
#define IN(k) (lo <= (k) && (k) < hi)
#define SEAM(k) do { if (IN(k) && IN((k) + 1)) { XcdBarrier bb_ = bar; asm volatile("" : "+s"(bb_.bar), "+s"(bb_.x));     \
    xcd_barrier(bb_); if (REPEAT_MASK & 512) xcd_barrier(bb_); } } while (0)

#ifndef OATT_FAST
#define OATT_FAST 1
#endif
#ifndef E_PARTS
#define E_PARTS 31
#endif
#define EP(b) ((E_PARTS & (b)) != 0)
#ifndef OCMP_FAST
#define OCMP_FAST 1
#endif
#ifndef ESCAN_FAST
#define ESCAN_FAST 1
#endif
#ifndef SKIP_MASK
#define SKIP_MASK 0
#endif
#define RP(b) (((REPEAT_MASK & (b)) != 0) ? 2 : 1)
#define SK(b) ((SKIP_MASK & (b)) != 0)
    if (IN(0)) {
        if (!SK(1)) for (int rp = 0; rp < RP(1); ++rp) { p0_prologue(p, lds, true); p0_extra(p, lds); }
        if (!SK(2)) nrm_phase<false, true, true, false>(p.x, nullptr, nullptr, nullptr, (GAS bf16*)(p.ws + WS_U), (GAS float*)(p.ws + WS_RS));
    }
    SEAM(0);

#pragma unroll 1
    for (int L = 0; L < 4; ++L) {
        const int odd = L & 1, j = L >> 1, base = 1 + 9 * L;
        GAS unsigned char* ws = p.ws; asm volatile("" : "+s"(ws)); ws = gptr(ws);
        GAS bf16* U = (GAS bf16*)(ws + WS_U); GAS bf16* Z = (GAS bf16*)(ws + WS_Z); GAS bf16* OMIX = (GAS bf16*)(ws + WS_OMIX); GAS bf16* MM = (GAS bf16*)(ws + WS_MM); GAS bf16* HID = (GAS bf16*)(ws + WS_HID);
        if (IN(base + 0)) {
            const int N = odd ? ZO : ZE;
            const GAS bf16* Bt = odd ? (const GAS bf16*)(ws + WS_WIN_O) + (size_t)j * ZO * D : (const GAS bf16*)(ws + WS_WIN_E) + (size_t)j * ZE * D;
            pg8::Gemm g{(const pg8::bf16_t*)(U), (const pg8::bf16_t*)(Bt), M, N, D}; pg8::StaticOrder S; S.init(M, N, G, bx);
            pg8::EpiBf16Plain E{Z, N};
            if (!SK(4)) for (int rp = 0; rp < RP(4) * RP(4096); ++rp) pg8::gemm_phase<pg8::EpiBf16Plain, pg8::StaticOrder, true, true>(lds, g, S, E);
            { const int nun = (M / 256) * (N / 256), rem = nun % G;
              if (!SK(2)) { if (rem == 0) gate_phase(p, lds, odd, j, bx, G); else gate_phase(p, lds, odd, j, bx >= rem ? bx - rem : -1, G - rem); } }
        }
        SEAM(base + 0);
        if (IN(base + 1)) {
            if (odd) { for (int rp = 0; rp < RP(16); ++rp) for (int unit = bx; unit < 256; unit += G) if (!SK(16)) { if (OCMP_FAST) ocmp_fast(p, lds, unit, j); else ocmp_slow(p, lds, unit, j); } }
            else {
#if ESCAN_FAST
                for (int rp = 0; rp < RP(8) * RP(64); ++rp) for (int u = bx; u < 2048; u += G) if (!SK(8)) { if (u < 1024) { if (EP(1)) for (int r2 = 0; r2 < RP(1024); ++r2) ea_gdn(p, lds, u, j); } else { if (EP(2)) for (int r2 = 0; r2 < RP(2048); ++r2) ea_hgrn(p, lds, u - 1024, j); } }
#else
                for (int rp = 0; rp < RP(8); ++rp) for (int unit = bx; unit < 64; unit += G) if (!SK(8)) escan_slow(p, lds, unit, j);
#endif
            }
        }
        SEAM(base + 1);
        if (IN(base + 2)) {
            if (odd) {
#if OATT_FAST
                for (int rp = 0; rp < RP(32); ++rp) for (int u = bx; u < 512; u += G) { const int bq = u & 255, rnd = u >> 8, bg = (bq & 7) * 2 + ((bq >> 3) & 1), pp = bq >> 4;
                    if (!SK(32)) oatt_fast(p, lds, bg >> 2, bg & 3, rnd ? 31 - pp : pp); }
#else
                for (int rp = 0; rp < RP(32); ++rp) for (int unit = bx; unit < 4096; unit += G) if (!SK(32)) oatt_slow(p, lds, unit);
#endif
            } else {
#if ESCAN_FAST
                for (int rp = 0; rp < RP(8) * RP(128); ++rp) for (int s = bx; s < 256; s += G) if (!SK(8)) { const int xc = s & 7, kk = (s >> 3) & 15, bh = xc * 4 + (kk >> 2), sl = kk & 3;
                    if (s < 128) { if (EP(4)) eb_scan<1>(p, lds, bh, sl); } else { if (EP(8)) eb_scan<0>(p, lds, bh, sl); } }
#endif
            }
        }
        SEAM(base + 2);
        if (IN(base + 3)) {
#if ESCAN_FAST
            if (!odd && !SK(8) && EP(16)) for (int rp = 0; rp < RP(256); ++rp) ec_phase(p, j);
#endif
        }
        if (!odd) SEAM(base + 3);
        if (IN(base + 4)) {
            const GAS bf16* Bt = (odd ? (const GAS bf16*)(ws + WS_WOUT_O) : (const GAS bf16*)(ws + WS_WOUT_E)) + (size_t)j * D * D;
            pg8::Gemm g{(const pg8::bf16_t*)(OMIX), (const pg8::bf16_t*)(Bt), M, D, D}; pg8::StaticOrder S; S.init(M, D, G, bx);
            pg8::EpiBf16Plain E{MM, D};
            if (!SK(4)) for (int rp = 0; rp < RP(4) * RP(8192); ++rp) pg8::gemm_phase<pg8::EpiBf16Plain, pg8::StaticOrder, true, true>(lds, g, S, E);
        }
        SEAM(base + 4);
        if (IN(base + 5) && !SK(2)) { const GAS float* g_res = p.norm_g + (size_t)(L * 4 + 1) * D; GAS float* RS = (GAS float*)(ws + WS_RS);
            if (L == 0) nrm_phase<true, true, true, false>(p.x, nullptr, MM, g_res, U, RS); else nrm_phase<true, true, false, false>(nullptr, nullptr, MM, g_res, U, RS); }
        SEAM(base + 5);
        if (IN(base + 6)) {
            pg8::Gemm g{(const pg8::bf16_t*)(U), (const pg8::bf16_t*)((const GAS bf16*)(ws + WS_WGU) + (size_t)L * 2 * DFF * D), M, 2 * DFF, D}; pg8::StaticOrder S; S.init(M, 2 * DFF, G, bx);
            pg8::EpiSwiglu E{HID, DFF};
#ifdef GU_COLD_PROBE
            { pg8::Gemm g2{(const pg8::bf16_t*)(U), (const pg8::bf16_t*)((const GAS bf16*)(ws + WS_WGU) + (size_t)((L + 2) & 3) * 2 * DFF * D), M, 2 * DFF, D}; pg8::EpiSwiglu E2{(GAS bf16*)(ws + 752 * MiB), DFF};
              pg8::gemm_phase<pg8::EpiSwiglu, pg8::StaticOrder, true, true>(lds, g2, S, E2); }
#endif
            if (!SK(4)) for (int rp = 0; rp < RP(4) * RP(16384); ++rp) pg8::gemm_phase<pg8::EpiSwiglu, pg8::StaticOrder, true, true>(lds, g, S, E);
        }
        SEAM(base + 6);
        if (IN(base + 7)) {
            pg8::Gemm g{(const pg8::bf16_t*)(HID), (const pg8::bf16_t*)((const GAS bf16*)(ws + WS_WDN) + (size_t)L * D * DFF), M, D, DFF}; pg8::StaticOrder S; S.init(M, D, G, bx);
            pg8::EpiBf16Plain E{MM, D};
            if (!SK(4)) for (int rp = 0; rp < RP(4) * RP(32768); ++rp) pg8::gemm_phase<pg8::EpiBf16Plain, pg8::StaticOrder, true, true>(lds, g, S, E);
        }
        SEAM(base + 7);
        if (IN(base + 8) && !SK(2)) {
            const GAS float* g_res = p.norm_g + (size_t)(L * 4 + 3) * D; GAS float* RS = (GAS float*)(ws + WS_RS);
            if (L == 3) nrm_phase<true, false, false, true>(nullptr, p.out, MM, g_res, U, RS);
            else nrm_phase<true, true, false, false>(nullptr, nullptr, MM, g_res, U, RS);
        }
        SEAM(base + 8);
    }
#undef IN
#undef SEAM
}

extern "C" void kernel_launch(void* const* d_in, const int* in_sizes, int n_in, void* d_out, int out_size, void* d_ws, size_t ws_size, hipStream_t stream) {
    static int grid = 0;
    if (grid == 0) {
        if (n_in != 17 || in_sizes[0] != M * D || out_size != M * D || ws_size < WS_END) { fprintf(stderr, "kernel_launch: unexpected shapes (n_in %d, in0 %d, out %d, ws %zu); nothing launched\n", n_in, n_in > 0 ? in_sizes[0] : -1, out_size, ws_size); grid = -1; return; }
        int dev = 0, cus = 0, per_cu = 0;
        if (hipGetDevice(&dev) != hipSuccess || hipDeviceGetAttribute(&cus, hipDeviceAttributeMultiprocessorCount, dev) != hipSuccess) { grid = -1; return; }
        if (hipFuncSetAttribute((const void*)fwd, hipFuncAttributeMaxDynamicSharedMemorySize, LDS_BYTES) != hipSuccess) { fprintf(stderr, "kernel_launch: hipFuncSetAttribute failed\n"); grid = -1; return; }
        if (hipOccupancyMaxActiveBlocksPerMultiprocessor(&per_cu, (const void*)fwd, NWAVES * 64, LDS_BYTES) != hipSuccess || per_cu < 1)
            fprintf(stderr, "kernel_launch: note: occupancy query reports %d workgroups per CU\n", per_cu);
        (void)hipGetLastError();
        grid = cus;
    }
    if (grid < 0) return;
    if (hipMemsetAsync((char*)d_ws + WS_CTL, 0, CTL_ZERO_BYTES, stream) != hipSuccess) return;
    Params p{};
    p.x = (const GAS float*)d_in[0]; p.norm_g = (const GAS float*)d_in[1]; p.ab_w_in = (const GAS float*)d_in[2]; p.hgrn_lb = (const GAS float*)d_in[3]; p.conv_w = (const GAS float*)d_in[4];
    p.a_log = (const GAS float*)d_in[5]; p.dt_bias = (const GAS float*)d_in[6]; p.hgrn_g = (const GAS float*)d_in[7]; p.gdn_g = (const GAS float*)d_in[8]; p.ab_w_out = (const GAS float*)d_in[9];
    p.nsa_w_in = (const GAS float*)d_in[10]; p.cmp_pos = (const GAS float*)d_in[11]; p.cmp_w1 = (const GAS float*)d_in[12]; p.cmp_w2 = (const GAS float*)d_in[13]; p.nsa_w_out = (const GAS float*)d_in[14];
    p.w_gu = (const GAS float*)d_in[15]; p.w_dn = (const GAS float*)d_in[16];
    p.out = (GAS float*)d_out; p.ws = (GAS unsigned char*)d_ws;
#if MK_PER_PHASE
#ifndef MK_NPH
#define MK_NPH N_PHASES
#endif
    for (int ph = 0; ph < MK_NPH; ++ph) { p.ph_lo = ph; p.ph_hi = ph + 1; hipLaunchKernelGGL(fwd, dim3(grid), dim3(NWAVES * 64), LDS_BYTES, stream, p); }
#else
    p.ph_lo = 0; p.ph_hi = N_PHASES;
    hipLaunchKernelGGL(fwd, dim3(grid), dim3(NWAVES * 64), LDS_BYTES, stream, p);
#endif
    const hipError_t le = hipPeekAtLastError();
    if (le != hipSuccess) fprintf(stderr, "kernel_launch: launch failed: %s\n", hipGetErrorName(le));
}
```

```cpp
#include <hip/hip_runtime.h>
#include <cstdio>
#include <cstdint>
#define MK_PER_PHASE 0
namespace pg8 {
#define PG8_LAS __attribute__((address_space(3)))
typedef unsigned short bf16_t;
typedef short bf16x8 __attribute__((ext_vector_type(8)));
typedef float f32x4 __attribute__((ext_vector_type(4)));
typedef unsigned u32x4 __attribute__((ext_vector_type(4)));
constexpr int BM = 256, BK = 64, HALF = 128, HTB = HALF * BK * 2  , STAGE_BYTES = 8 * HTB, NXCD = 8, WGM = 8;

__host__ __device__ __forceinline__ int lds_byte(int r, int c) { const int st = (r >> 4) * 2 + (c >> 5), rr = r & 15, cc = c & 31, ob = rr * 64 + cc * 2; return st * 1024 + (ob ^ (((ob >> 9) & 1) << 5)); }
__host__ __device__ __forceinline__ void stage_rc(int b, int& R, int& C) { const int st = b / 1024, sb = b % 1024, swz = sb ^ (((sb >> 9) & 1) << 5); R = (st >> 1) * 16 + swz / 64; C = (st & 1) * 32 + (swz % 64) / 2; }
__host__ __device__ __forceinline__ int perm32(int rho) { const int n = rho >> 4, i = rho & 15; return 8 * (i >> 2) + 4 * n + (i & 3); }

struct Unit { int pm, pn; };
struct Gemm { const bf16_t* A; const bf16_t* Bt; int M, N, K; };

struct StaticOrder {
    int nM, nN, nwg, G, c;
    __host__ __device__ void init(int M, int N, int G_, int c_) { nM = M / BM; nN = N / BM; nwg = nM * nN; G = G_; c = c_; }
    __host__ __device__ bool next(int i, Unit& u) const {
        const long L = (long)i * G + c; if (L >= nwg) return false;
        int wgid = (int)L; { const int q = nwg / NXCD, r = nwg % NXCD, xcd = wgid % NXCD, off = wgid / NXCD; wgid = (xcd < r ? xcd * (q + 1) : r * (q + 1) + (xcd - r) * q) + off; }
        const int nig = WGM * nN, gid = wgid / nig, fm = gid * WGM, gsz = (nM - fm) < WGM ? (nM - fm) : WGM;
        u.pm = fm + ((wgid % nig) % gsz); u.pn = (wgid % nig) / gsz; return true;
    }
    __device__ __forceinline__ void a_ready(const Unit&) const {}
    __device__ __forceinline__ void done(const Unit&) const {}
};

__device__ __forceinline__ unsigned cvt_pk_bf16(float lo, float hi) { unsigned r; asm volatile("v_cvt_pk_bf16_f32 %0, %1, %2" : "=v"(r) : "v"(lo), "v"(hi)); return r; }
#ifndef GAS
#define GAS __attribute__((address_space(1)))
#endif

__device__ __forceinline__ float silu_f(float x) { return x * __builtin_amdgcn_rcpf(1.0f + __builtin_amdgcn_exp2f(x * -1.4426950408889634f)); }
struct EpiBf16Plain {
    static constexpr bool PERM = true, AFTER_DRAIN = false;
    GAS bf16_t* O; int ldc;
    __device__ __forceinline__ void operator()(const f32x4 (&acc)[2][2][4][2], const Unit& u, int wr, int wc, int fr, int fq) const {
        const int row0 = u.pm * BM + wr * 64 + fr, col0 = u.pn * BM + wc * 32 + 8 * fq;
#pragma unroll
        for (int ai = 0; ai < 2; ++ai)
#pragma unroll
            for (int m = 0; m < 4; ++m) { GAS bf16_t* rowp = O + (size_t)(row0 + ai * HALF + m * 16) * ldc + col0;
#pragma unroll
                for (int bj = 0; bj < 2; ++bj) { const f32x4 v0 = acc[ai][bj][m][0], v1 = acc[ai][bj][m][1];
                    u32x4 w; w.x = cvt_pk_bf16(v0[0], v0[1]); w.y = cvt_pk_bf16(v0[2], v0[3]); w.z = cvt_pk_bf16(v1[0], v1[1]); w.w = cvt_pk_bf16(v1[2], v1[3]);
                    *(GAS u32x4*)(rowp + bj * HALF) = w; } }
    }
};
struct EpiSwiglu {
    static constexpr bool PERM = true, AFTER_DRAIN = false;
    GAS bf16_t* O; int ldc;
    __device__ __forceinline__ void operator()(const f32x4 (&acc)[2][2][4][2], const Unit& u, int wr, int wc, int fr, int fq) const {
        const int row0 = u.pm * BM + wr * 64 + fr, col0 = u.pn * HALF + wc * 32 + 8 * fq;
#pragma unroll
        for (int ai = 0; ai < 2; ++ai)
#pragma unroll
            for (int m = 0; m < 4; ++m) { GAS bf16_t* rowp = O + (size_t)(row0 + ai * HALF + m * 16) * ldc + col0;
                const f32x4 g0 = acc[ai][0][m][0], g1 = acc[ai][0][m][1], u0 = acc[ai][1][m][0], u1 = acc[ai][1][m][1];
                u32x4 w;
                w.x = cvt_pk_bf16(silu_f(g0[0]) * u0[0], silu_f(g0[1]) * u0[1]); w.y = cvt_pk_bf16(silu_f(g0[2]) * u0[2], silu_f(g0[3]) * u0[3]);
                w.z = cvt_pk_bf16(silu_f(g1[0]) * u1[0], silu_f(g1[1]) * u1[1]); w.w = cvt_pk_bf16(silu_f(g1[2]) * u1[2], silu_f(g1[3]) * u1[3]);
                *(GAS u32x4*)rowp = w; }
    }
};
struct EpiF32 {
    static constexpr bool PERM = false, AFTER_DRAIN = false;
    GAS float* C; int ldc;
    __device__ __forceinline__ void operator()(const f32x4 (&acc)[2][2][4][2], const Unit& u, int wr, int wc, int fr, int fq) const {
        const int row0 = u.pm * BM + wr * 64 + fr, col0 = u.pn * BM + wc * 32 + 4 * fq;
#pragma unroll
        for (int ai = 0; ai < 2; ++ai)
#pragma unroll
            for (int m = 0; m < 4; ++m) { GAS float* rowp = C + (size_t)(row0 + ai * HALF + m * 16) * ldc + col0;
#pragma unroll
                for (int bj = 0; bj < 2; ++bj)
#pragma unroll
                    for (int n = 0; n < 2; ++n) *(GAS f32x4*)(rowp + bj * HALF + n * 16) = acc[ai][bj][m][n]; }
    }
};
template <class Epi, class Sched, bool ALIGN_EPI = false, bool SP2 = false>
__device__ __forceinline__ void gemm_phase(PG8_LAS unsigned char* lds, const Gemm g, const Sched& S, const Epi& E) {
    int tid_l = threadIdx.x; asm volatile("" : "+v"(tid_l));
    const char* gA_ = (const char*)(g.A); const char* gB_ = (const char*)(g.Bt); asm volatile("" : "+s"(gA_), "+s"(gB_));
    const int tid = tid_l, wid = __builtin_amdgcn_readfirstlane(tid >> 6), lane = tid & 63, wr = wid >> 2, wc = wid & 3, fr = lane & 15, fq = lane >> 4;
    const int K = g.K, nt = K / BK;
    unsigned voffA[2], voffB[2];
#pragma unroll
    for (int i = 0; i < 2; ++i) { int R, C; stage_rc(tid * 16 + i * 8192, R, C); const int Rb = Epi::PERM ? ((R & ~31) + perm32(R & 31)) : R;
        voffA[i] = (unsigned)(R * K + C) * 2u; voffB[i] = (unsigned)(Rb * K + C) * 2u; }
    const size_t kstep = (size_t)(BK * 2);
    const size_t hstep = (size_t)HALF * K * 2;
    const size_t tstep = 2 * hstep;
    const unsigned ldsw = (unsigned)wid * 1024u;
    const int aoff = lds_byte(wr * 64 + fr, fq * 8), boff = lds_byte(wc * 32 + fr, fq * 8);
#define PG8_SA(b, h) (((b) * 2 + (h)) * HTB)
#define PG8_SB(b, h) ((4 + (b) * 2 + (h)) * HTB)
#define PG8_STAGE(bufoff, gbase, voff) do { _Pragma("unroll") for (int _i = 0; _i < 2; ++_i) \
        __builtin_amdgcn_global_load_lds((const unsigned*)((const char*)(gbase) + (voff)[_i]), (PG8_LAS unsigned*)(lds + (bufoff) + ldsw + _i * 8192), 16, 0, 0); } while (0)
#define PG8_LDA(dst, b, h) do { _Pragma("unroll") for (int m = 0; m < 4; ++m) _Pragma("unroll") for (int k = 0; k < 2; ++k) dst[m][k] = *(const PG8_LAS bf16x8*)(lds + PG8_SA(b, h) + aoff + m * 2048 + k * 1024); } while (0)
#define PG8_LDB(dst, b, h) do { _Pragma("unroll") for (int n = 0; n < 2; ++n) _Pragma("unroll") for (int k = 0; k < 2; ++k) dst[n][k] = *(const PG8_LAS bf16x8*)(lds + PG8_SB(b, h) + boff + n * 2048 + k * 1024); } while (0)
#define PG8_MMA(ai, bj, At, Bt) do { __builtin_amdgcn_s_setprio(1); _Pragma("unroll") for (int m = 0; m < 4; ++m) _Pragma("unroll") for (int n = 0; n < 2; ++n) _Pragma("unroll") for (int k = 0; k < 2; ++k) \
        acc[ai][bj][m][n] = __builtin_amdgcn_mfma_f32_16x16x32_bf16(Bt[n][k], At[m][k], acc[ai][bj][m][n], 0, 0, 0); __builtin_amdgcn_s_setprio(0); } while (0)
#define PG8_WAIT_V(n) asm volatile("s_waitcnt vmcnt(" #n ")" ::: "memory")
#define PG8_WAIT_L(n) asm volatile("s_waitcnt lgkmcnt(" #n ")" ::: "memory")
#define PG8_BAR __builtin_amdgcn_s_barrier()
#define PG8_SCHED __builtin_amdgcn_sched_barrier(0)
    Unit cur, nxt; int ui = 0;
    if (!S.next(0, cur)) return;
    f32x4 acc[2][2][4][2];
#pragma unroll
    for (int a = 0; a < 2; ++a)
#pragma unroll
        for (int b = 0; b < 2; ++b)
#pragma unroll
            for (int m = 0; m < 4; ++m)
#pragma unroll
                for (int n = 0; n < 2; ++n) acc[a][b][m][n] = (f32x4){0.f, 0.f, 0.f, 0.f};
    bf16x8 At[4][2], B0[2][2], B1[2][2];
    const char* cA = gA_ + (size_t)cur.pm * tstep; const char* cB = gB_ + (size_t)cur.pn * tstep;
    S.a_ready(cur);
    if constexpr (SP2) {
        PG8_STAGE(PG8_SB(0, 0), cB, voffB); PG8_STAGE(PG8_SB(0, 1), cB + hstep, voffB); PG8_STAGE(PG8_SA(0, 0), cA, voffA); PG8_STAGE(PG8_SA(0, 1), cA + hstep, voffA);
        if (wr == 1) PG8_BAR;
        PG8_WAIT_V(2); PG8_BAR;
        PG8_STAGE(PG8_SB(1, 0), cB + kstep, voffB); PG8_STAGE(PG8_SA(1, 0), cA + kstep, voffA); PG8_STAGE(PG8_SB(1, 1), cB + hstep + kstep, voffB);
        PG8_WAIT_V(6); PG8_BAR;
    } else {
        PG8_STAGE(PG8_SB(0, 0), cB, voffB); PG8_STAGE(PG8_SA(0, 0), cA, voffA); PG8_STAGE(PG8_SB(0, 1), cB + hstep, voffB); PG8_STAGE(PG8_SA(0, 1), cA + hstep, voffA);
        if (wr == 1) PG8_BAR;
        PG8_WAIT_V(4); PG8_BAR;
        PG8_STAGE(PG8_SB(1, 0), cB + kstep, voffB); PG8_STAGE(PG8_SA(1, 0), cA + kstep, voffA); PG8_STAGE(PG8_SB(1, 1), cB + hstep + kstep, voffB);
        PG8_WAIT_V(6); PG8_BAR;
    }
    for (;;) {
        const bool has_next = S.next(ui + 1, nxt);
        const char* nA = has_next ? gA_ + (size_t)nxt.pm * tstep : cA; const char* nB = has_next ? gB_ + (size_t)nxt.pn * tstep : cB;
        for (int t = 0; t < nt; t += 2) {
            const bool last = (t == nt - 2);
            const char* a1 = cA + (size_t)(t + 1) * kstep;
            const char* a2 = last ? nA : cA + (size_t)(t + 2) * kstep; const char* b2 = last ? nB : cB + (size_t)(t + 2) * kstep;
            const char* a3 = a2 + kstep; const char* b3 = b2 + kstep;
            if (last && has_next) S.a_ready(nxt);
            if constexpr (SP2) {
            PG8_LDB(B0, 0, 0); PG8_LDB(B1, 0, 1); PG8_SCHED; PG8_LDA(At, 0, 0); PG8_STAGE(PG8_SA(1, 1), a1 + hstep, voffA);
            PG8_WAIT_V(8); PG8_WAIT_L(0); PG8_BAR; PG8_MMA(0, 0, At, B0); PG8_MMA(0, 1, At, B1); PG8_BAR; PG8_SCHED;
            PG8_LDA(At, 0, 1); PG8_STAGE(PG8_SB(0, 0), b2, voffB); PG8_STAGE(PG8_SB(0, 1), b2 + hstep, voffB); PG8_STAGE(PG8_SA(0, 0), a2, voffA);
            PG8_WAIT_V(8); PG8_WAIT_L(0); PG8_BAR; PG8_MMA(1, 0, At, B0); PG8_MMA(1, 1, At, B1); PG8_BAR; PG8_SCHED;
            PG8_LDB(B0, 1, 0); PG8_LDB(B1, 1, 1); PG8_SCHED; PG8_LDA(At, 1, 0); PG8_STAGE(PG8_SA(0, 1), a2 + hstep, voffA);
            PG8_WAIT_V(8); PG8_WAIT_L(0); PG8_BAR; PG8_MMA(0, 0, At, B0); PG8_MMA(0, 1, At, B1); PG8_BAR; PG8_SCHED;
            PG8_LDA(At, 1, 1); PG8_STAGE(PG8_SB(1, 0), b3, voffB); PG8_STAGE(PG8_SB(1, 1), b3 + hstep, voffB); PG8_STAGE(PG8_SA(1, 0), a3, voffA);
            PG8_WAIT_V(8); PG8_WAIT_L(0); PG8_BAR; PG8_MMA(1, 0, At, B0); PG8_MMA(1, 1, At, B1); PG8_BAR; PG8_SCHED;
            } else {
            PG8_LDB(B0, 0, 0); PG8_SCHED; PG8_LDA(At, 0, 0); PG8_STAGE(PG8_SA(1, 1), a1 + hstep, voffA);
            PG8_WAIT_L(8); PG8_BAR; PG8_WAIT_L(0); PG8_MMA(0, 0, At, B0); PG8_BAR; PG8_SCHED;
            PG8_LDB(B1, 0, 1); PG8_STAGE(PG8_SB(0, 0), b2, voffB);
            PG8_BAR; PG8_WAIT_L(0); PG8_MMA(0, 1, At, B1); PG8_BAR;
            PG8_LDA(At, 0, 1); PG8_STAGE(PG8_SA(0, 0), a2, voffA);
            PG8_BAR; PG8_WAIT_L(0); PG8_MMA(1, 0, At, B0); PG8_BAR; PG8_SCHED;
            PG8_STAGE(PG8_SB(0, 1), b2 + hstep, voffB);
            PG8_WAIT_V(6); PG8_BAR; PG8_MMA(1, 1, At, B1); PG8_BAR;
            PG8_LDB(B0, 1, 0); PG8_SCHED; PG8_LDA(At, 1, 0); PG8_STAGE(PG8_SA(0, 1), a2 + hstep, voffA);
            PG8_WAIT_L(8); PG8_BAR; PG8_WAIT_L(0); PG8_MMA(0, 0, At, B0); PG8_BAR; PG8_SCHED;
            PG8_LDB(B1, 1, 1); PG8_STAGE(PG8_SB(1, 0), b3, voffB);
            PG8_BAR; PG8_WAIT_L(0); PG8_MMA(0, 1, At, B1); PG8_BAR;
            PG8_LDA(At, 1, 1); PG8_STAGE(PG8_SA(1, 0), a3, voffA);
            PG8_BAR; PG8_WAIT_L(0); PG8_MMA(1, 0, At, B0); PG8_BAR; PG8_SCHED;
            PG8_STAGE(PG8_SB(1, 1), b3 + hstep, voffB);
            PG8_WAIT_V(6); PG8_BAR; PG8_MMA(1, 1, At, B1); PG8_BAR;
            }
        }
        if constexpr (ALIGN_EPI) { if (wr == 0) PG8_BAR; }
        if constexpr (!Epi::AFTER_DRAIN) { E(acc, cur, wr, wc, fr, fq); S.done(cur); }
        if (!has_next) break;
#pragma unroll
        for (int a = 0; a < 2; ++a)
#pragma unroll
            for (int b = 0; b < 2; ++b)
#pragma unroll
                for (int m = 0; m < 4; ++m)
#pragma unroll
                    for (int n = 0; n < 2; ++n) acc[a][b][m][n] = (f32x4){0.f, 0.f, 0.f, 0.f};
        cur = nxt; cA = nA; cB = nB; ++ui;
        if constexpr (ALIGN_EPI) { if (wr == 1) PG8_BAR; }
    }
    PG8_WAIT_V(0);
    if constexpr (!ALIGN_EPI) { if (wr == 0) PG8_BAR; }
    PG8_BAR;
    if constexpr (Epi::AFTER_DRAIN) { E.fused(acc, cur, wr, wc, fr, fq, lds, wid, lane); S.done(cur); }
#undef PG8_SA
#undef PG8_SB
#undef PG8_STAGE
#undef PG8_LDA
#undef PG8_LDB
#undef PG8_MMA
#undef PG8_WAIT_V
#undef PG8_WAIT_L
#undef PG8_BAR
#undef PG8_SCHED
}
}

constexpr int NWAVES = 8;
constexpr int NB = 4, T = 2048, M = NB * T, D = 2048, DFF = 5632;
constexpr int EVEN_IN = 8208, ODD_IN = 5168, ZE = 8192, ZO = 5120;
constexpr float EPS = 1e-6f;
#ifndef MK_PER_PHASE
#define MK_PER_PHASE 0
#endif
constexpr int N_PHASES = 37;

constexpr size_t MiB = 1u << 20;
constexpr size_t WS_CTL = 0, CTL_ZERO_BYTES = 1 * MiB;
constexpr size_t WS_WIN_E = 2 * MiB;
constexpr size_t WS_WOUT_E = 66 * MiB;
constexpr size_t WS_WIN_O = 82 * MiB;
constexpr size_t WS_WOUT_O = 122 * MiB;
constexpr size_t WS_WGU = 138 * MiB;
constexpr size_t WS_WDN = 314 * MiB;
constexpr size_t WS_U = 402 * MiB;
constexpr size_t WS_Z = 434 * MiB;
constexpr size_t WS_OMIX = 562 * MiB;
constexpr size_t WS_MM = 594 * MiB;
constexpr size_t WS_HID = 658 * MiB;
constexpr size_t WS_GATES = 746 * MiB;
constexpr size_t WS_CMP = 748 * MiB;
constexpr size_t WS_RS = 978 * MiB;
constexpr size_t WS_END = 1010 * MiB;
constexpr int CW_BAR = 4096;

constexpr int RING_BYTES = 131072, LDS_BYTES = 147456, LDSCTL_OFF = LDS_BYTES - 1024, MISC_OFF = LDSCTL_OFF + 320;

#ifndef GAS
#define GAS __attribute__((address_space(1)))
#endif
#define LAS __attribute__((address_space(3)))
typedef unsigned short bf16;
typedef unsigned v4u __attribute__((ext_vector_type(4)));
typedef unsigned v2u __attribute__((ext_vector_type(2)));
typedef float f32x4 __attribute__((ext_vector_type(4)));
typedef float f32x2v __attribute__((ext_vector_type(2)));
#define LDS_WAIT() asm volatile("s_waitcnt lgkmcnt(0)" ::: "memory")
#define VM_WAIT() asm volatile("s_waitcnt vmcnt(0)" ::: "memory")
__device__ __forceinline__ unsigned f2bf(float f) { unsigned u = __builtin_bit_cast(unsigned, f); return (u + 0x7fffu + ((u >> 16) & 1u)) >> 16; }
__device__ __forceinline__ unsigned pk2s(float lo, float hi) { return f2bf(lo) | (f2bf(hi) << 16); }
__device__ __forceinline__ unsigned pk2(float lo, float hi) { unsigned r; asm("v_cvt_pk_bf16_f32 %0, %1, %2" : "=v"(r) : "v"(lo), "v"(hi)); return r; }
__device__ __forceinline__ float bflo(unsigned w) { return __builtin_bit_cast(float, w << 16); }
__device__ __forceinline__ float bfhi(unsigned w) { return __builtin_bit_cast(float, w & 0xffff0000u); }
__device__ __forceinline__ float sigmoid_f(float x) { return __builtin_amdgcn_rcpf(1.0f + __builtin_amdgcn_exp2f(x * -1.4426950408889634f)); }
__device__ __forceinline__ float silu2_f(float x) { return x * __builtin_amdgcn_rcpf(1.0f + __builtin_amdgcn_exp2f(x * -1.4426950408889634f)); }
__device__ __forceinline__ float wave_sum(float v) {
#pragma unroll
    for (int o = 1; o < 64; o <<= 1) v += __shfl_xor(v, o);
    return v;
}
__device__ __forceinline__ float wave_max(float v) {
#pragma unroll
    for (int o = 1; o < 64; o <<= 1) v = fmaxf(v, __shfl_xor(v, o));
    return v;
}
#define PHASE_IDS() int tid = threadIdx.x; asm volatile("" : "+v"(tid)); const int lane = tid & 63, wave = __builtin_amdgcn_readfirstlane(tid >> 6); (void)lane; (void)wave
#define XB_TMO      128
#define XB_XCNT(j)  (256  + 64 * (j))
#define XB_XSUB(j)  (1280 + 64 * (j))
#define XB_XGEN(j)  (2304 + 64 * (j))
#define XB_TOP      3328
#define XB_TOPGEN   3392
#define XCD_BAR_WORDS 3456
#define XB_SPIN_CAP (1u << 22)

__device__ __forceinline__ unsigned xb_ld(unsigned* p)              { return __hip_atomic_load(p, __ATOMIC_RELAXED, __HIP_MEMORY_SCOPE_AGENT); }
__device__ __forceinline__ unsigned xb_add(unsigned* p, unsigned v) { return __hip_atomic_fetch_add(p, v, __ATOMIC_RELAXED, __HIP_MEMORY_SCOPE_AGENT); }
__device__ __forceinline__ unsigned xb_xcc_id() { return (unsigned)__builtin_amdgcn_s_getreg((3 << 11) | 20) & 0xFu; }
#define XB_SPIN(cond, bar) do { unsigned _sp = 0; while (cond) { __builtin_amdgcn_s_sleep(1); \
    if ((++_sp & 255u) == 0u) { if (xb_ld(&(bar)[XB_TMO])) break; if (_sp > XB_SPIN_CAP) { atomicAdd(&(bar)[XB_TMO], 1u); break; } } } } while (0)

struct XcdBarrier {
    unsigned* bar; unsigned x;
    volatile LAS unsigned* st;
};

__device__ __forceinline__ XcdBarrier xcd_barrier_post(unsigned* bar, volatile LAS unsigned* st) {
    XcdBarrier b; b.bar = bar; b.x = xb_xcc_id(); b.st = st;
    if (threadIdx.x == 0) (void)xb_add(&bar[XB_XCNT(b.x)], 1u);
    return b;
}
__device__ __forceinline__ void xcd_barrier_complete(unsigned* bar, unsigned x, unsigned& nloc, unsigned& nx) {
    const unsigned G = gridDim.x * gridDim.y * gridDim.z;
    unsigned sum, cnt, mine, sp = 0u;
    for (;;) {
        sum = 0u; cnt = 0u; mine = 0u;
#pragma unroll
        for (unsigned j = 0; j < 16; ++j) { const unsigned c = xb_ld(&bar[XB_XCNT(j)]); sum += c; cnt += (c > 0u) ? 1u : 0u; mine = (j == x) ? c : mine; }
        if (sum == G) break;
        __builtin_amdgcn_s_sleep(1);
        if ((++sp & 255u) == 0u) { if (xb_ld(&bar[XB_TMO])) break; if (sp > XB_SPIN_CAP) { atomicAdd(&bar[XB_TMO], 1u); break; } }
    }
    nloc = mine > 0u ? mine : 1u; nx = cnt > 0u ? cnt : 1u;
}

__device__ __forceinline__ void xcd_barrier(const XcdBarrier& b) {
    asm volatile("s_waitcnt vmcnt(0)" ::: "memory");
    __syncthreads();
    if (threadIdx.x == 0) {
        unsigned* bar = b.bar;
        __builtin_amdgcn_s_waitcnt(0);
        unsigned nloc = b.st[0], nx = b.st[1];
        if (nloc == 0u) { xcd_barrier_complete(bar, b.x, nloc, nx); b.st[0] = nloc; b.st[1] = nx; }
        const unsigned old = xb_add(&bar[XB_XSUB(b.x)], 1u);
        const unsigned gen = old / nloc;
        if (old + 1u == (gen + 1u) * nloc) {
            __builtin_amdgcn_fence(__ATOMIC_RELEASE, "agent");
            asm volatile("s_waitcnt vmcnt(0)" ::: "memory");
            const unsigned og = xb_add(&bar[XB_TOP], 1u);
            const unsigned tg = og / nx;
            if (og + 1u == (tg + 1u) * nx) xb_add(&bar[XB_TOPGEN], 1u);
            else XB_SPIN(xb_ld(&bar[XB_TOPGEN]) == tg, bar);
            __builtin_amdgcn_fence(__ATOMIC_ACQUIRE, "agent");
            xb_add(&bar[XB_XGEN(b.x)], 1u);
            asm volatile("s_waitcnt vmcnt(0)" ::: "memory");
        } else {
            XB_SPIN(xb_ld(&bar[XB_XGEN(b.x)]) == gen, bar);
            __builtin_amdgcn_fence(__ATOMIC_ACQUIRE, "agent");
            asm volatile("s_waitcnt vmcnt(0)" ::: "memory");
        }
    }
    __syncthreads();
}

struct Params {
    const GAS float* x; const GAS float* norm_g; const GAS float* ab_w_in; const GAS float* hgrn_lb; const GAS float* conv_w; const GAS float* a_log; const GAS float* dt_bias;
    const GAS float* hgrn_g; const GAS float* gdn_g; const GAS float* ab_w_out; const GAS float* nsa_w_in; const GAS float* cmp_pos; const GAS float* cmp_w1; const GAS float* cmp_w2;
    const GAS float* nsa_w_out; const GAS float* w_gu; const GAS float* w_dn;
    GAS float* out; GAS unsigned char* ws; int ph_lo, ph_hi;
};
template <class T> __device__ __forceinline__ T* gptr(T* q) {
#if defined(__HIP_DEVICE_COMPILE__)
    __builtin_assume(!__builtin_amdgcn_is_shared((const void*)q)); __builtin_assume(!__builtin_amdgcn_is_private((const void*)q));
#endif
    return q; }
#define GLOBAL_PARAMS(p) do { p.ws = gptr(p.ws); p.x = gptr(p.x); p.norm_g = gptr(p.norm_g); p.ab_w_in = gptr(p.ab_w_in); p.hgrn_lb = gptr(p.hgrn_lb); p.conv_w = gptr(p.conv_w); p.a_log = gptr(p.a_log); \
    p.dt_bias = gptr(p.dt_bias); p.hgrn_g = gptr(p.hgrn_g); p.gdn_g = gptr(p.gdn_g); p.ab_w_out = gptr(p.ab_w_out); p.nsa_w_in = gptr(p.nsa_w_in); p.cmp_pos = gptr(p.cmp_pos); p.cmp_w1 = gptr(p.cmp_w1); \
    p.cmp_w2 = gptr(p.cmp_w2); p.nsa_w_out = gptr(p.nsa_w_out); p.w_gu = gptr(p.w_gu); p.w_dn = gptr(p.w_dn); p.out = gptr(p.out); } while (0)

__device__ __forceinline__ void tr_item(const GAS float* W, int ldw, int K, GAS bf16* WT, int n0, int r0, int k0, LAS float* scr, int lane, const GAS float* gk) {
#pragma unroll 8
    for (int i = 0; i < 32; ++i) { const int kk = 2 * i + (lane >> 5); scr[kk * 33 + (lane & 31)] = W[(size_t)(k0 + kk) * ldw + n0 + (lane & 31)]; }
    LDS_WAIT(); asm volatile("" ::: "memory");
    const int c = lane & 7;
    f32x4 ga = (f32x4){1.f, 1.f, 1.f, 1.f}, gb = ga;
    if (gk) { ga = *(const GAS f32x4*)(gk + k0 + 8 * c); gb = *(const GAS f32x4*)(gk + k0 + 8 * c + 4); }
#pragma unroll
    for (int j = 0; j < 4; ++j) { const int n = (lane >> 3) + 8 * j; const LAS float* s = scr + (8 * c) * 33 + n;
        v4u o; o.x = pk2(s[0 * 33] * ga[0], s[1 * 33] * ga[1]); o.y = pk2(s[2 * 33] * ga[2], s[3 * 33] * ga[3]); o.z = pk2(s[4 * 33] * gb[0], s[5 * 33] * gb[1]); o.w = pk2(s[6 * 33] * gb[2], s[7 * 33] * gb[3]);
        *(GAS v4u*)(WT + (size_t)(r0 + n) * K + k0 + 8 * c) = o; }
    LDS_WAIT(); asm volatile("" ::: "memory");
}
__device__ __forceinline__ void tr_matrix(const GAS float* W, int ldw, int K, int ncols, GAS bf16* WT, int mode, LAS float* scr, int gw, int NGW, int lane, const GAS float* gk = nullptr) {
    const int nblk = ncols / 32, nitems = (K / 64) * nblk;
    for (int it = gw; it < nitems; it += NGW) {
        const int kb = it / nblk, nb = it % nblk, n0 = nb * 32;
        int r0 = n0;
        if (mode == 1) { r0 = (n0 < DFF) ? (n0 / 128) * 256 + (n0 % 128) : ((n0 - DFF) / 128) * 256 + 128 + ((n0 - DFF) % 128); }
        tr_item(W, ldw, K, WT, n0, r0, kb * 64, scr, lane, gk);
    }
}
__device__ __forceinline__ void conv_weight(const Params& p, int what, int idx, LAS float* scr, int gw, int NGW, int lane) {
    GAS unsigned char* ws = p.ws;
    if (what == 0) tr_matrix(p.ab_w_in + (size_t)idx * D * EVEN_IN, EVEN_IN, D, ZE, (GAS bf16*)(ws + WS_WIN_E) + (size_t)idx * ZE * D, 0, scr, gw, NGW, lane, p.norm_g + (size_t)((2 * idx) * 4 + 0) * D);
    else if (what == 1) tr_matrix(p.ab_w_out + (size_t)idx * D * D, D, D, D, (GAS bf16*)(ws + WS_WOUT_E) + (size_t)idx * D * D, 0, scr, gw, NGW, lane);
    else if (what == 2) tr_matrix(p.nsa_w_in + (size_t)idx * D * ODD_IN, ODD_IN, D, ZO, (GAS bf16*)(ws + WS_WIN_O) + (size_t)idx * ZO * D, 0, scr, gw, NGW, lane, p.norm_g + (size_t)((2 * idx + 1) * 4 + 0) * D);
    else if (what == 3) tr_matrix(p.nsa_w_out + (size_t)idx * D * D, D, D, D, (GAS bf16*)(ws + WS_WOUT_O) + (size_t)idx * D * D, 0, scr, gw, NGW, lane);
    else if (what == 4) tr_matrix(p.w_gu + (size_t)idx * D * 2 * DFF, 2 * DFF, D, 2 * DFF, (GAS bf16*)(ws + WS_WGU) + (size_t)idx * 2 * DFF * D, 1, scr, gw, NGW, lane, p.norm_g + (size_t)(idx * 4 + 2) * D);
    else tr_matrix(p.w_dn + (size_t)idx * DFF * D, D, DFF, D, (GAS bf16*)(ws + WS_WDN) + (size_t)idx * D * DFF, 0, scr, gw, NGW, lane);
}
#ifndef CONV_SPLIT_G
#define CONV_SPLIT_G 235
#endif
#ifndef CV_NB
#define CV_NB 2
#endif
struct CvDesc { const GAS float* W; GAS bf16* WT; const GAS float* gk; int ldw, K, nblk, mode; };
struct CvSet { const GAS float* src; GAS bf16* dst; const GAS float* gk; int ldw, K, hasg; };
__device__ __forceinline__ CvDesc cv_desc(const Params& p, int what, int idx) {
    GAS unsigned char* ws = p.ws;
    if (what == 0) return CvDesc{p.ab_w_in + (size_t)idx * D * EVEN_IN, (GAS bf16*)(ws + WS_WIN_E) + (size_t)idx * ZE * D, p.norm_g + (size_t)((2 * idx) * 4 + 0) * D, EVEN_IN, D, ZE / 32, 0};
    if (what == 1) return CvDesc{p.ab_w_out + (size_t)idx * D * D, (GAS bf16*)(ws + WS_WOUT_E) + (size_t)idx * D * D, nullptr, D, D, D / 32, 0};
    if (what == 2) return CvDesc{p.nsa_w_in + (size_t)idx * D * ODD_IN, (GAS bf16*)(ws + WS_WIN_O) + (size_t)idx * ZO * D, p.norm_g + (size_t)((2 * idx + 1) * 4 + 0) * D, ODD_IN, D, ZO / 32, 0};
    if (what == 3) return CvDesc{p.nsa_w_out + (size_t)idx * D * D, (GAS bf16*)(ws + WS_WOUT_O) + (size_t)idx * D * D, nullptr, D, D, D / 32, 0};
    if (what == 4) return CvDesc{p.w_gu + (size_t)idx * D * 2 * DFF, (GAS bf16*)(ws + WS_WGU) + (size_t)idx * 2 * DFF * D, p.norm_g + (size_t)(idx * 4 + 2) * D, 2 * DFF, D, 2 * DFF / 32, 1};
    return CvDesc{p.w_dn + (size_t)idx * DFF * D, (GAS bf16*)(ws + WS_WDN) + (size_t)idx * D * DFF, nullptr, D, DFF, D / 32, 0};
}
__device__ __forceinline__ int cv_what(int L, int q) { return q == 0 ? 5 : q == 1 ? 4 : q == 2 ? ((L & 1) ? 3 : 1) : ((L & 1) ? 2 : 0); }
__device__ __forceinline__ int cv_idx(int L, int q) { return q < 2 ? L : (L >> 1); }
__device__ __forceinline__ int cv_n(int what) { return what == 0 ? (D / 64) * (ZE / 32) : what == 2 ? (D / 64) * (ZO / 32) : what == 4 ? (D / 64) * (2 * DFF / 32) : what == 5 ? (DFF / 64) * (D / 32) : (D / 64) * (D / 32); }
__device__ __forceinline__ int cv_total(int L, int qlo, int qhi) { int t = 0; for (int q = qlo; q < qhi; ++q) t += cv_n(cv_what(L, q)); return t; }
__device__ __forceinline__ CvSet cv_decode(const Params& p, int L, int qhi, int it, int& seg, int& segbase) {
    while (seg < qhi - 1 && it >= segbase + cv_n(cv_what(L, seg))) { segbase += cv_n(cv_what(L, seg)); ++seg; }
    const CvDesc d = cv_desc(p, cv_what(L, seg), cv_idx(L, seg));
    const int li = it - segbase, kb = li / d.nblk, nb = li - kb * d.nblk, n0 = nb * 32, k0 = kb * 64;
    int r0 = n0;
    if (d.mode == 1) { r0 = (n0 < DFF) ? (n0 / 128) * 256 + (n0 % 128) : ((n0 - DFF) / 128) * 256 + 128 + ((n0 - DFF) % 128); }
    CvSet s; s.src = d.W + (size_t)k0 * d.ldw + n0; s.dst = d.WT + (size_t)r0 * d.K + k0; s.gk = (d.gk ? d.gk : p.norm_g) + k0; s.hasg = d.gk ? 1 : 0; s.ldw = d.ldw; s.K = d.K; return s;
}
__device__ __forceinline__ void cv_load(const CvSet& st, int lane, f32x4 (&t)[8], f32x4& ga, f32x4& gb) {
    const GAS float* s = st.src + (size_t)(lane >> 3) * st.ldw + (lane & 7) * 4;
#pragma unroll
    for (int i = 0; i < 8; ++i) t[i] = *(const GAS f32x4*)(s + (size_t)(8 * i) * st.ldw);
    ga = *(const GAS f32x4*)(st.gk + 8 * (lane & 7)); gb = *(const GAS f32x4*)(st.gk + 8 * (lane & 7) + 4);
}
template <bool NT> __device__ __forceinline__ void cv_fin(const CvSet& st, int lane, const f32x4 (&t)[8], const f32x4 ga_, const f32x4 gb_, LAS float* scr) {
    const f32x4 one = (f32x4){1.f, 1.f, 1.f, 1.f}; const f32x4 ga = st.hasg ? ga_ : one, gb = st.hasg ? gb_ : one;
    LAS float* d = scr + (lane >> 3) * 33 + (lane & 7) * 4;
#pragma unroll
    for (int i = 0; i < 8; ++i) { d[264 * i + 0] = t[i][0]; d[264 * i + 1] = t[i][1]; d[264 * i + 2] = t[i][2]; d[264 * i + 3] = t[i][3]; }
    LDS_WAIT(); asm volatile("" ::: "memory");
    const int c = lane & 7;
#pragma unroll
    for (int j = 0; j < 4; ++j) { const int n = (lane >> 3) + 8 * j; const LAS float* s = scr + (8 * c) * 33 + n;
        v4u o; o.x = pk2(s[0 * 33] * ga[0], s[1 * 33] * ga[1]); o.y = pk2(s[2 * 33] * ga[2], s[3 * 33] * ga[3]); o.z = pk2(s[4 * 33] * gb[0], s[5 * 33] * gb[1]); o.w = pk2(s[6 * 33] * gb[2], s[7 * 33] * gb[3]);
        { GAS v4u* q = (GAS v4u*)(st.dst + (size_t)n * st.K + 8 * c); if (NT) __builtin_nontemporal_store(o, q); else *q = o; } }
    LDS_WAIT(); asm volatile("" ::: "memory");
}
template <bool NT> __device__ __forceinline__ void conv_layer(const Params& p0, LAS unsigned char* lds, int L, int qlo, int qhi, int wgi, int nwgs) {
    PHASE_IDS(); Params p = p0; asm volatile("" : "+s"(p.ws)); GLOBAL_PARAMS(p);
    const int gw = wgi * NWAVES + wave, NGW = nwgs * NWAVES, TOT = cv_total(L, qlo, qhi);
    LAS float* scr = (LAS float*)(lds + wave * 16384);
    constexpr int NB = CV_NB;
    int seg = qlo, segbase = 0;
    f32x4 buf[NB][8], ga[NB], gb[NB]; CvSet st[NB];
    const int nw = gw < TOT ? (TOT - gw + NGW - 1) / NGW : 0;
#define CV_ITEM(k) ((gw + (k) * NGW) < TOT ? (gw + (k) * NGW) : TOT - 1)
#pragma unroll
    for (int s = 0; s < NB; ++s) { st[s] = cv_decode(p, L, qhi, CV_ITEM(s), seg, segbase); cv_load(st[s], lane, buf[s], ga[s], gb[s]); }
    int i = 0;
    for (; i + NB <= nw; i += NB) {
#pragma unroll
        for (int s = 0; s < NB; ++s) { cv_fin<NT>(st[s], lane, buf[s], ga[s], gb[s], scr); st[s] = cv_decode(p, L, qhi, CV_ITEM(i + s + NB), seg, segbase); cv_load(st[s], lane, buf[s], ga[s], gb[s]); }
    }
#pragma unroll
    for (int s = 0; s < NB; ++s) if (i + s < nw) cv_fin<NT>(st[s], lane, buf[s], ga[s], gb[s], scr);
#undef CV_ITEM
}
__device__ __forceinline__ void p0_prologue(const Params& p0, LAS unsigned char* lds, bool all) {
    (void)all; const bool split = CONV_SPLIT_G > 0 && (int)gridDim.x > CONV_SPLIT_G;
    if (!split) { for (int L = 3; L >= 0; --L) conv_layer<false>(p0, lds, L, 0, 4, blockIdx.x, gridDim.x); }
    else { for (int L = 3; L >= 1; --L) conv_layer<false>(p0, lds, L, 3, 4, blockIdx.x, gridDim.x); conv_layer<false>(p0, lds, 0, 0, 4, blockIdx.x, gridDim.x); }
}
template <int NX> __device__ __forceinline__ void gate_dots(const LAS float* su, const GAS float* wx, int ldw, int lane, GAS float* grow) {
    float acc[NX];
#pragma unroll
    for (int c = 0; c < NX; ++c) acc[c] = 0.f;
#pragma unroll 2
    for (int it = 0; it < 32; ++it) { const int k = it * 64 + lane; const float uu = su[k]; const GAS f32x4* wp = (const GAS f32x4*)(wx + (size_t)k * ldw);
#pragma unroll
        for (int c4 = 0; c4 < NX / 4; ++c4) { const f32x4 w = wp[c4]; acc[4 * c4 + 0] += uu * w[0]; acc[4 * c4 + 1] += uu * w[1]; acc[4 * c4 + 2] += uu * w[2]; acc[4 * c4 + 3] += uu * w[3]; } }
#pragma unroll
    for (int c = 0; c < NX; ++c) { const float s = wave_sum(acc[c]); if (lane == 0) grow[c] = s; }
}
template <int CTRL> __device__ __forceinline__ float dpp_mov0(float v) { return __builtin_bit_cast(float, __builtin_amdgcn_update_dpp(0, __builtin_bit_cast(int, v), CTRL, 0xf, 0xf, true)); }
__device__ __forceinline__ float wave_sum_fast(float v) {
    v += dpp_mov0<0xB1>(v); v += dpp_mov0<0x4E>(v); v += dpp_mov0<0x141>(v); v += dpp_mov0<0x140>(v);
    return __builtin_bit_cast(float, __builtin_amdgcn_readlane(__builtin_bit_cast(int, v), 0)) + __builtin_bit_cast(float, __builtin_amdgcn_readlane(__builtin_bit_cast(int, v), 16))
         + __builtin_bit_cast(float, __builtin_amdgcn_readlane(__builtin_bit_cast(int, v), 32)) + __builtin_bit_cast(float, __builtin_amdgcn_readlane(__builtin_bit_cast(int, v), 48));
}
template <bool HAS_MM, bool HAS_U, bool HIN_F32, bool HOUT_F32>
__device__ __forceinline__ void nrm_phase(const GAS float* hin, GAS float* hout, const GAS bf16* mm, const GAS float* g_res, GAS bf16* U, GAS float* RS) {
    PHASE_IDS(); const int gw = blockIdx.x * NWAVES + wave, NGW = gridDim.x * NWAVES;
    for (int row0 = gw; row0 < M; row0 += 2 * NGW) {
        const int row1 = row0 + NGW; const bool two = row1 < M; const int r1 = two ? row1 : row0;
        f32x4 ha[8], hb[8]; v2u ua_[8], ub_[8], wa[8], wb[8]; f32x4 gg[8]; float rsa = 1.f, rsb = 1.f;
        if (HIN_F32) { const GAS f32x4* pa = (const GAS f32x4*)(hin + (size_t)row0 * D) + lane; const GAS f32x4* pb = (const GAS f32x4*)(hin + (size_t)r1 * D) + lane;
#pragma unroll
          for (int j = 0; j < 8; ++j) { ha[j] = pa[64 * j]; hb[j] = pb[64 * j]; }
        } else { const GAS v2u* pa = (const GAS v2u*)(U + (size_t)row0 * D) + lane; const GAS v2u* pb = (const GAS v2u*)(U + (size_t)r1 * D) + lane; rsa = RS[row0]; rsb = RS[r1];
#pragma unroll
          for (int j = 0; j < 8; ++j) { ua_[j] = pa[64 * j]; ub_[j] = pb[64 * j]; } }
        if (HAS_MM) { const GAS v2u* ma = (const GAS v2u*)(mm + (size_t)row0 * D) + lane; const GAS v2u* mb = (const GAS v2u*)(mm + (size_t)r1 * D) + lane;
#pragma unroll
            for (int j = 0; j < 8; ++j) { wa[j] = ma[64 * j]; wb[j] = mb[64 * j]; }
#pragma unroll
            for (int j = 0; j < 8; ++j) gg[j] = ((const GAS f32x4*)g_res)[lane + 64 * j]; }
        __builtin_amdgcn_sched_barrier(0);
        if (!HIN_F32) { const float ia = __builtin_amdgcn_rcpf(rsa), ib = __builtin_amdgcn_rcpf(rsb);
#pragma unroll
          for (int j = 0; j < 8; ++j) { const v2u a = ua_[j], b2 = ub_[j]; ha[j] = (f32x4){bflo(a.x), bfhi(a.x), bflo(a.y), bfhi(a.y)} * ia; hb[j] = (f32x4){bflo(b2.x), bfhi(b2.x), bflo(b2.y), bfhi(b2.y)} * ib; } }
        if (HAS_MM) {
            float sa = 0.f, sb = 0.f;
#pragma unroll
            for (int j = 0; j < 8; ++j) { const float a0 = bflo(wa[j].x), a1 = bfhi(wa[j].x), a2 = bflo(wa[j].y), a3 = bfhi(wa[j].y), b0 = bflo(wb[j].x), b1 = bfhi(wb[j].x), b2 = bflo(wb[j].y), b3 = bfhi(wb[j].y);
                sa += (a0 * a0 + a1 * a1) + (a2 * a2 + a3 * a3); sb += (b0 * b0 + b1 * b1) + (b2 * b2 + b3 * b3); }
            sa = wave_sum_fast(sa); sb = wave_sum_fast(sb);
            const float ra = __builtin_amdgcn_rsqf(sa * (1.0f / D) + EPS), rb = __builtin_amdgcn_rsqf(sb * (1.0f / D) + EPS);
#pragma unroll
            for (int j = 0; j < 8; ++j) { const f32x4 g = gg[j];
                ha[j] = ha[j] + (f32x4){bflo(wa[j].x), bfhi(wa[j].x), bflo(wa[j].y), bfhi(wa[j].y)} * ra * g; hb[j] = hb[j] + (f32x4){bflo(wb[j].x), bfhi(wb[j].x), bflo(wb[j].y), bfhi(wb[j].y)} * rb * g; }
            if (HOUT_F32) { GAS f32x4* oa = (GAS f32x4*)(hout + (size_t)row0 * D) + lane; GAS f32x4* ob = (GAS f32x4*)(hout + (size_t)r1 * D) + lane;
#pragma unroll
                for (int j = 0; j < 8; ++j) { oa[64 * j] = ha[j]; if (two) ob[64 * j] = hb[j]; } }
        }
        if (HAS_U) {
            float sa = 0.f, sb = 0.f;
#pragma unroll
            for (int j = 0; j < 8; ++j) { sa += (ha[j][0] * ha[j][0] + ha[j][1] * ha[j][1]) + (ha[j][2] * ha[j][2] + ha[j][3] * ha[j][3]); sb += (hb[j][0] * hb[j][0] + hb[j][1] * hb[j][1]) + (hb[j][2] * hb[j][2] + hb[j][3] * hb[j][3]); }
            sa = wave_sum_fast(sa); sb = wave_sum_fast(sb);
            const float ra = __builtin_amdgcn_rsqf(sa * (1.0f / D) + EPS), rb = __builtin_amdgcn_rsqf(sb * (1.0f / D) + EPS);
            GAS v2u* ua = (GAS v2u*)(U + (size_t)row0 * D) + lane; GAS v2u* ub = (GAS v2u*)(U + (size_t)r1 * D) + lane;
#pragma unroll
            for (int j = 0; j < 8; ++j) { const f32x4 xa = ha[j] * ra, xb = hb[j] * rb;
                v2u w; w.x = pk2(xa[0], xa[1]); w.y = pk2(xa[2], xa[3]); ua[64 * j] = w; if (two) { v2u w2; w2.x = pk2(xb[0], xb[1]); w2.y = pk2(xb[2], xb[3]); ub[64 * j] = w2; } }
            if (lane == 0) { RS[row0] = ra; if (two) RS[row1] = rb; }
        }
    }
}

template <int CTRL> __device__ __forceinline__ float dpp_mov(float v) { return __builtin_bit_cast(float, __builtin_amdgcn_update_dpp(0, __builtin_bit_cast(int, v), CTRL, 0xf, 0xf, true)); }
__device__ __forceinline__ float row16_sum(float v) { v += dpp_mov<0xB1>(v); v += dpp_mov<0x4E>(v); v += dpp_mov<0x141>(v); v += dpp_mov<0x140>(v); return v; }
__device__ __forceinline__ void escan_slow(const Params& p0, LAS unsigned char* lds, int unit, int je) {
    PHASE_IDS(); Params p = p0; asm volatile("" : "+s"(p.ws)); GLOBAL_PARAMS(p);
    const int mixer = unit >> 5, b = (unit >> 3) & 3, h = unit & 7;
    LAS float* sQ = (LAS float*)lds; LAS float* sF = sQ + 4096; LAS float* sV = sF + 4096; LAS float* sO = sV + 4096; LAS float* sAB = sO + 4096;
    const GAS bf16* Z = (const GAS bf16*)(p.ws + WS_Z); const GAS float* gates = (const GAS float*)(p.ws + WS_GATES); GAS bf16* OMIX = (GAS bf16*)(p.ws + WS_OMIX);
    const int dgrp = lane & 15, egrp = wave * 4 + (lane >> 4), d0 = dgrp * 8, e0 = egrp * 4;
    float S[8][4];
#pragma unroll
    for (int dd = 0; dd < 8; ++dd)
#pragma unroll
        for (int ee = 0; ee < 4; ++ee) S[dd][ee] = 0.f;
    for (int t0 = 0; t0 < T; t0 += 32) {
        if (mixer == 0) {
            const int tt = tid >> 4, c8 = (tid & 15) * 8; const size_t m = (size_t)b * T + t0 + tt;
            const v4u qw = *(const GAS v4u*)(Z + m * ZE + h * 128 + c8), fw = *(const GAS v4u*)(Z + m * ZE + 1024 + h * 128 + c8), vw = *(const GAS v4u*)(Z + m * ZE + 2048 + h * 128 + c8);
            float q8[8] = {bflo(qw.x), bfhi(qw.x), bflo(qw.y), bfhi(qw.y), bflo(qw.z), bfhi(qw.z), bflo(qw.w), bfhi(qw.w)};
            float f8[8] = {bflo(fw.x), bfhi(fw.x), bflo(fw.y), bfhi(fw.y), bflo(fw.z), bfhi(fw.z), bflo(fw.w), bfhi(fw.w)};
            float v8[8] = {bflo(vw.x), bfhi(vw.x), bflo(vw.y), bfhi(vw.y), bflo(vw.z), bfhi(vw.z), bflo(vw.w), bfhi(vw.w)};
#pragma unroll
            for (int i = 0; i < 8; ++i) { const int ch = h * 128 + c8 + i;
                const float lb = je ? sigmoid_f(p.hgrn_lb[1024 + ch] - p.hgrn_lb[ch]) : 0.f;
                const float f = lb + (1.0f - lb) * sigmoid_f(f8[i]);
                sQ[tt * 128 + c8 + i] = q8[i]; sF[tt * 128 + c8 + i] = f; sV[tt * 128 + c8 + i] = v8[i]; }
        } else {
            for (int it = tid; it < 1536; it += 512) {
                const int tt = it / 48, cc = it % 48, which = cc >> 4, c8 = (cc & 15) * 8;
                const int zcol = 4096 + which * 1024 + h * 128 + c8, wcol = which * 1024 + h * 128 + c8;
                float acc[8];
#pragma unroll
                for (int i = 0; i < 8; ++i) acc[i] = 0.f;
#pragma unroll
                for (int kk = 0; kk < 4; ++kk) { const int tpos = t0 + tt - 3 + kk;
                    if (tpos >= 0) { const v4u zw = *(const GAS v4u*)(Z + ((size_t)b * T + tpos) * ZE + zcol); const GAS float* cw = p.conv_w + ((size_t)(je * 4 + kk)) * 3072 + wcol;
                        const f32x4 w0 = *(const GAS f32x4*)cw, w1 = *(const GAS f32x4*)(cw + 4);
                        acc[0] += w0[0] * bflo(zw.x); acc[1] += w0[1] * bfhi(zw.x); acc[2] += w0[2] * bflo(zw.y); acc[3] += w0[3] * bfhi(zw.y);
                        acc[4] += w1[0] * bflo(zw.z); acc[5] += w1[1] * bfhi(zw.z); acc[6] += w1[2] * bflo(zw.w); acc[7] += w1[3] * bfhi(zw.w); } }
                LAS float* dst = (which == 0 ? sQ : (which == 1 ? sF : sV)) + tt * 128 + c8;
#pragma unroll
                for (int i = 0; i < 8; ++i) dst[i] = silu2_f(acc[i]);
            }
            if (tid < 32) { const size_t m = (size_t)b * T + t0 + tid; const float ba = gates[m * 64 + h], bb = gates[m * 64 + 8 + h];
                const float xx = ba + p.dt_bias[je * 8 + h]; const float sp = xx > 20.f ? xx : __logf(1.0f + __expf(xx));
                const float ld = -__expf(p.a_log[je * 8 + h]) * sp; sAB[2 * tid] = __expf(ld); sAB[2 * tid + 1] = sigmoid_f(bb); }
            __syncthreads();
#pragma unroll 1
            for (int r = 0; r < 8; ++r) { const int pair = wave * 8 + r, tt = pair >> 1, which = pair & 1; LAS float* ptr = (which ? sF : sQ) + tt * 128;
                const float a0 = ptr[2 * lane], a1 = ptr[2 * lane + 1]; const float ss = wave_sum(a0 * a0 + a1 * a1);
                const float sc = (1.0f / sqrtf(ss + 1e-6f)) * (which ? 1.0f : 0.08838834764831845f); ptr[2 * lane] = a0 * sc; ptr[2 * lane + 1] = a1 * sc; }
        }
        __syncthreads();
#pragma unroll 4
        for (int tt = 0; tt < 32; ++tt) {
            const f32x4 qa = *(const LAS f32x4*)(sQ + tt * 128 + d0), qb = *(const LAS f32x4*)(sQ + tt * 128 + d0 + 4);
            const f32x4 fa = *(const LAS f32x4*)(sF + tt * 128 + d0), fb = *(const LAS f32x4*)(sF + tt * 128 + d0 + 4);
            const f32x4 v4 = *(const LAS f32x4*)(sV + tt * 128 + e0);
            const float q8[8] = {qa[0], qa[1], qa[2], qa[3], qb[0], qb[1], qb[2], qb[3]};
            const float f8[8] = {fa[0], fa[1], fa[2], fa[3], fb[0], fb[1], fb[2], fb[3]};
            float o4[4] = {0.f, 0.f, 0.f, 0.f};
            if (mixer == 0) {
#pragma unroll
                for (int dd = 0; dd < 8; ++dd) { const float kd = 1.0f - f8[dd];
#pragma unroll
                    for (int ee = 0; ee < 4; ++ee) { S[dd][ee] = f8[dd] * S[dd][ee] + kd * v4[ee]; o4[ee] += S[dd][ee] * q8[dd]; } }
            } else {
                const float a = sAB[2 * tt], beta = sAB[2 * tt + 1];
                float ks[4] = {0.f, 0.f, 0.f, 0.f};
#pragma unroll
                for (int dd = 0; dd < 8; ++dd)
#pragma unroll
                    for (int ee = 0; ee < 4; ++ee) { S[dd][ee] *= a; ks[ee] += f8[dd] * S[dd][ee]; }
#pragma unroll
                for (int ee = 0; ee < 4; ++ee) ks[ee] = row16_sum(ks[ee]);
                float dl[4];
#pragma unroll
                for (int ee = 0; ee < 4; ++ee) dl[ee] = beta * (v4[ee] - ks[ee]);
#pragma unroll
                for (int dd = 0; dd < 8; ++dd)
#pragma unroll
                    for (int ee = 0; ee < 4; ++ee) { S[dd][ee] += f8[dd] * dl[ee]; o4[ee] += S[dd][ee] * q8[dd]; }
            }
#pragma unroll
            for (int ee = 0; ee < 4; ++ee) o4[ee] = row16_sum(o4[ee]);
            if (dgrp == 0) *(LAS f32x4*)(sO + tt * 128 + e0) = (f32x4){o4[0], o4[1], o4[2], o4[3]};
        }
        __syncthreads();
#pragma unroll 1
        for (int r = 0; r < 4; ++r) { const int tt = wave * 4 + r; const size_t m = (size_t)b * T + t0 + tt;
            const float o0 = sO[tt * 128 + 2 * lane], o1 = sO[tt * 128 + 2 * lane + 1];
            const float ss = wave_sum(o0 * o0 + o1 * o1); const float rstd = 1.0f / sqrtf(ss * (1.0f / 128.0f) + EPS);
            const int gcol = (mixer ? 7168 : 3072) + h * 128 + 2 * lane; const unsigned gw2 = *(const GAS unsigned*)(Z + m * ZE + gcol);
            const GAS float* gn = (mixer ? p.gdn_g : p.hgrn_g) + je * 128 + 2 * lane;
            const float r0 = o0 * rstd * gn[0] * silu2_f(bflo(gw2)), r1 = o1 * rstd * gn[1] * silu2_f(bfhi(gw2));
            *(GAS unsigned*)(OMIX + m * D + mixer * 1024 + h * 128 + 2 * lane) = pk2(r0, r1); }
    }
    __syncthreads();
}

__device__ __forceinline__ void ocmp_slow(const Params& p0, LAS unsigned char* lds, int unit, int jo) {
    PHASE_IDS(); Params p = p0; asm volatile("" : "+s"(p.ws)); GLOBAL_PARAMS(p);
    const int kv = unit >> 7, b = (unit >> 5) & 3, g = (unit >> 3) & 3, jb = unit & 7;
    LAS float* sA = (LAS float*)lds;
    const GAS bf16* Z = (const GAS bf16*)(p.ws + WS_Z); GAS bf16* CMP = (GAS bf16*)(p.ws + WS_CMP);
    const GAS float* pos = p.cmp_pos + (size_t)(jo * 2 + kv) * 32 * 128; const GAS float* w1 = p.cmp_w1 + (size_t)(jo * 2 + kv) * 4096 * 128; const GAS float* w2 = p.cmp_w2 + (size_t)(jo * 2 + kv) * 128 * 128;
    const int n = tid & 127, rg = tid >> 7, zc = 2048 + kv * 512 + g * 128;
    float acc[4] = {0.f, 0.f, 0.f, 0.f};
    for (int l = 0; l < 32; ++l) {
        __syncthreads();
#pragma unroll
        for (int e = 0; e < 4; ++e) { const int idx = tid + 512 * e, r = idx >> 7, d = idx & 127, j = jb * 16 + r; float v = 0.f;
            if (j < 127) { const int tok = 16 * j + l; const unsigned short zz = Z[((size_t)b * T + tok) * ZO + zc + d]; v = bflo((unsigned)zz) + pos[l * 128 + d]; }
            sA[r * 128 + d] = v; }
        __syncthreads();
        const GAS float* wl = w1 + (size_t)(l * 128) * 128 + n;
#pragma unroll 4
        for (int k4 = 0; k4 < 32; ++k4) {
            const float wa = wl[(size_t)(4 * k4 + 0) * 128], wb = wl[(size_t)(4 * k4 + 1) * 128], wc = wl[(size_t)(4 * k4 + 2) * 128], wd = wl[(size_t)(4 * k4 + 3) * 128];
#pragma unroll
            for (int i = 0; i < 4; ++i) { const f32x4 a = *(const LAS f32x4*)(sA + (rg * 4 + i) * 128 + 4 * k4); acc[i] += a[0] * wa + a[1] * wb + a[2] * wc + a[3] * wd; }
        }
    }
    __syncthreads();
#pragma unroll
    for (int i = 0; i < 4; ++i) sA[(rg * 4 + i) * 128 + n] = silu2_f(acc[i]);
    __syncthreads();
    float o[4] = {0.f, 0.f, 0.f, 0.f};
#pragma unroll 4
    for (int k4 = 0; k4 < 32; ++k4) {
        const float wa = w2[(size_t)(4 * k4 + 0) * 128 + n], wb = w2[(size_t)(4 * k4 + 1) * 128 + n], wc = w2[(size_t)(4 * k4 + 2) * 128 + n], wd = w2[(size_t)(4 * k4 + 3) * 128 + n];
#pragma unroll
        for (int i = 0; i < 4; ++i) { const f32x4 a = *(const LAS f32x4*)(sA + (rg * 4 + i) * 128 + 4 * k4); o[i] += a[0] * wa + a[1] * wb + a[2] * wc + a[3] * wd; }
    }
#pragma unroll
    for (int i = 0; i < 4; ++i) { const int j = jb * 16 + rg * 4 + i; CMP[((size_t)((kv * 4 + b) * 4 + g) * 128 + j) * 128 + n] = (j < 127) ? (bf16)f2bf(o[i]) : (bf16)0; }
    __syncthreads();
}

template <bool F32ROW> __device__ __forceinline__ void dot4(const GAS void* row, const LAS float* sq, float (&d)[4]) {
    d[0] = d[1] = d[2] = d[3] = 0.f;
    if (F32ROW) { const GAS f32x4* r = (const GAS f32x4*)row;
#pragma unroll 4
        for (int c = 0; c < 32; ++c) { const f32x4 kv = r[c];
#pragma unroll
            for (int h = 0; h < 4; ++h) { const f32x4 q = *(const LAS f32x4*)(sq + h * 128 + 4 * c); d[h] += (kv[0] * q[0] + kv[1] * q[1]) + (kv[2] * q[2] + kv[3] * q[3]); } }
    } else { const GAS v4u* r = (const GAS v4u*)row;
#pragma unroll 4
        for (int c = 0; c < 16; ++c) { const v4u w = r[c];
            const float k0 = bflo(w.x), k1 = bfhi(w.x), k2 = bflo(w.y), k3 = bfhi(w.y), k4 = bflo(w.z), k5 = bfhi(w.z), k6 = bflo(w.w), k7 = bfhi(w.w);
#pragma unroll
            for (int h = 0; h < 4; ++h) { const f32x4 qa = *(const LAS f32x4*)(sq + h * 128 + 8 * c), qb = *(const LAS f32x4*)(sq + h * 128 + 8 * c + 4);
                d[h] += ((k0 * qa[0] + k1 * qa[1]) + (k2 * qa[2] + k3 * qa[3])) + ((k4 * qb[0] + k5 * qb[1]) + (k6 * qb[2] + k7 * qb[3])); } }
    }
}
__device__ __forceinline__ void oatt_slow(const Params& p0, LAS unsigned char* lds, int unit) {
    PHASE_IDS(); Params p = p0; asm volatile("" : "+s"(p.ws)); GLOBAL_PARAMS(p);
    const int t8 = unit & 255, g = (unit >> 8) & 3, b = unit >> 10, t = t8 * 8 + wave;
    LAS float* sq = (LAS float*)(lds + wave * 12288);
    LAS float* sp = sq + 512;
    const GAS bf16* Z = (const GAS bf16*)(p.ws + WS_Z); const GAS bf16* CMP = (const GAS bf16*)(p.ws + WS_CMP); const GAS float* gates = (const GAS float*)(p.ws + WS_GATES); GAS bf16* OMIX = (GAS bf16*)(p.ws + WS_OMIX);
    const size_t m = (size_t)b * T + t; const GAS bf16* zrow = Z + m * ZO; const float NEG = -__builtin_inff();
    float slope[4];
#pragma unroll
    for (int h = 0; h < 4; ++h) { const unsigned w = *(const GAS unsigned*)(zrow + (g * 4 + h) * 128 + 2 * lane); sq[h * 128 + 2 * lane] = bflo(w) * 0.08838834764831845f; sq[h * 128 + 2 * lane + 1] = bfhi(w) * 0.08838834764831845f;
        slope[h] = exp2f(-0.5f * (float)(g * 4 + h + 1)); }
    LDS_WAIT();
    const int ncv = t >= 31 ? ((t - 31) >> 4) + 1 : 0;
    const GAS bf16* CK = CMP + ((size_t)((0 * 4 + b) * 4 + g) * 128) * 128; const GAS bf16* CV = CMP + ((size_t)((1 * 4 + b) * 4 + g) * 128) * 128;
    float oc[4][2] = {{0.f, 0.f}, {0.f, 0.f}, {0.f, 0.f}, {0.f, 0.f}};
    {
        float sc[2][4];
#pragma unroll
        for (int jb = 0; jb < 2; ++jb) { const int j = jb * 64 + lane, jc = j < 126 ? j : 126; float d[4]; dot4<false>(CK + (size_t)jc * 128, sq, d);
#pragma unroll
            for (int h = 0; h < 4; ++h) sc[jb][h] = (j < ncv) ? d[h] - slope[h] * (float)(t - (16 * j + 31)) : NEG; }
#pragma unroll
        for (int h = 0; h < 4; ++h) { const float mx = wave_max(fmaxf(sc[0][h], sc[1][h]));
            const float ea = (lane < ncv) ? __expf(sc[0][h] - mx) : 0.f, eb = (64 + lane < ncv) ? __expf(sc[1][h] - mx) : 0.f;
            const float l = wave_sum(ea + eb); const float inv = ncv > 0 ? 1.0f / l : 0.f;
            sp[lane * 4 + h] = ea * inv; sp[(64 + lane) * 4 + h] = eb * inv; }
        LDS_WAIT();
        for (int j = 0; j < ncv; ++j) { const f32x4 p4 = *(const LAS f32x4*)(sp + 4 * j); const unsigned vw2 = *(const GAS unsigned*)(CV + (size_t)j * 128 + 2 * lane); const f32x2v v2 = {bflo(vw2), bfhi(vw2)};
#pragma unroll
            for (int h = 0; h < 4; ++h) { oc[h][0] += p4[h] * v2[0]; oc[h][1] += p4[h] * v2[1]; } }
    }
    const int cur = t >> 6;
    unsigned mask;
    {
        float score = -3.0e38f;
        if (lane < 32) { const int i = lane; int jlo = 4 * i - 1; if (jlo < 0) jlo = 0; int jhi = 4 * i + 3; if (jhi > 126) jhi = 126; float imp = 0.f;
            for (int j = jlo; j <= jhi; ++j) { const f32x4 p4 = *(const LAS f32x4*)(sp + 4 * j); imp += (p4[0] + p4[1]) + (p4[2] + p4[3]); }
            const bool forced = (i == 0) || (i == cur) || (i == cur - 1);
            score = forced ? 1.0e4f : (i > cur ? -1.0e4f : imp); }
        int rank = 0;
        for (int i2 = 0; i2 < 32; ++i2) { const float s2 = __shfl(score, i2); rank += ((s2 > score) || (s2 == score && i2 < lane)) ? 1 : 0; }
        const bool sel = (lane < 32) && (rank < 8) && (lane <= cur);
        mask = (unsigned)__ballot(sel);
    }
    LDS_WAIT();
    float os[4][2] = {{0.f, 0.f}, {0.f, 0.f}, {0.f, 0.f}, {0.f, 0.f}};
    {
        float smax[4] = {NEG, NEG, NEG, NEG}; int nb = 0;
        for (unsigned mm = mask; mm; mm &= mm - 1, ++nb) { const int i = __builtin_ctz(mm); const int kpos = 64 * i + lane; const int kc = kpos < t ? kpos : t; float d[4];
            dot4<false>(Z + ((size_t)b * T + kc) * ZO + 3072 + g * 128, sq, d);
            f32x4 s4;
#pragma unroll
            for (int h = 0; h < 4; ++h) { const float s = (kpos <= t) ? d[h] - slope[h] * (float)(t - kpos) : NEG; s4[h] = s; smax[h] = fmaxf(smax[h], s); }
            *(LAS f32x4*)(sp + (nb * 64 + lane) * 4) = s4; }
        const int nsel = nb;
#pragma unroll
        for (int h = 0; h < 4; ++h) smax[h] = wave_max(smax[h]);
        LDS_WAIT();
        float ls[4] = {0.f, 0.f, 0.f, 0.f};
        for (int r = 0; r < nsel; ++r) { f32x4 s4 = *(const LAS f32x4*)(sp + (r * 64 + lane) * 4);
#pragma unroll
            for (int h = 0; h < 4; ++h) { const float e = __expf(s4[h] - smax[h]); s4[h] = e; ls[h] += e; }
            *(LAS f32x4*)(sp + (r * 64 + lane) * 4) = s4; }
#pragma unroll
        for (int h = 0; h < 4; ++h) ls[h] = 1.0f / wave_sum(ls[h]);
        LDS_WAIT();
        nb = 0;
        for (unsigned mm = mask; mm; mm &= mm - 1, ++nb) { const int i = __builtin_ctz(mm); int kend = t - 64 * i; if (kend > 63) kend = 63;
            const GAS bf16* vb = Z + ((size_t)b * T + 64 * i) * ZO + 3584 + g * 128 + 2 * lane;
            for (int kk = 0; kk <= kend; ++kk) { const f32x4 p4 = *(const LAS f32x4*)(sp + (nb * 64 + kk) * 4); const unsigned w = *(const GAS unsigned*)(vb + (size_t)kk * ZO); const float v0 = bflo(w), v1 = bfhi(w);
#pragma unroll
                for (int h = 0; h < 4; ++h) { os[h][0] += p4[h] * v0; os[h][1] += p4[h] * v1; } } }
#pragma unroll
        for (int h = 0; h < 4; ++h) { os[h][0] *= ls[h]; os[h][1] *= ls[h]; }
    }
    LDS_WAIT();
    float ow[4][2] = {{0.f, 0.f}, {0.f, 0.f}, {0.f, 0.f}, {0.f, 0.f}};
    {
        const int w0 = t > 511 ? t - 511 : 0, nk = t - w0 + 1, nbat = (nk + 63) >> 6;
        float smax[4] = {NEG, NEG, NEG, NEG};
        for (int wb = 0; wb < nbat; ++wb) { const int idx = wb * 64 + lane; const int ic = idx < nk ? idx : nk - 1; const int kpos = w0 + ic; float d[4];
            dot4<false>(Z + ((size_t)b * T + kpos) * ZO + 4096 + g * 128, sq, d);
            f32x4 s4;
#pragma unroll
            for (int h = 0; h < 4; ++h) { const float s = (idx < nk) ? d[h] - slope[h] * (float)(t - kpos) : NEG; s4[h] = s; smax[h] = fmaxf(smax[h], s); }
            *(LAS f32x4*)(sp + idx * 4) = s4; }
#pragma unroll
        for (int h = 0; h < 4; ++h) smax[h] = wave_max(smax[h]);
        LDS_WAIT();
        float ls[4] = {0.f, 0.f, 0.f, 0.f};
        for (int wb = 0; wb < nbat; ++wb) { f32x4 s4 = *(const LAS f32x4*)(sp + (wb * 64 + lane) * 4);
#pragma unroll
            for (int h = 0; h < 4; ++h) { const float e = __expf(s4[h] - smax[h]); s4[h] = e; ls[h] += e; }
            *(LAS f32x4*)(sp + (wb * 64 + lane) * 4) = s4; }
#pragma unroll
        for (int h = 0; h < 4; ++h) ls[h] = 1.0f / wave_sum(ls[h]);
        LDS_WAIT();
        const GAS bf16* vb = Z + ((size_t)b * T + w0) * ZO + 4608 + g * 128 + 2 * lane;
        for (int kk = 0; kk < nk; ++kk) { const f32x4 p4 = *(const LAS f32x4*)(sp + kk * 4); const unsigned w = *(const GAS unsigned*)(vb + (size_t)kk * ZO); const float v0 = bflo(w), v1 = bfhi(w);
#pragma unroll
            for (int h = 0; h < 4; ++h) { ow[h][0] += p4[h] * v0; ow[h][1] += p4[h] * v1; } }
#pragma unroll
        for (int h = 0; h < 4; ++h) { ow[h][0] *= ls[h]; ow[h][1] *= ls[h]; }
    }
    LDS_WAIT();
#pragma unroll
    for (int h = 0; h < 4; ++h) { const GAS float* gl = gates + m * 64 + g * 12 + h * 3; const float g0 = sigmoid_f(gl[0]), g1 = sigmoid_f(gl[1]), g2 = sigmoid_f(gl[2]);
        const float r0 = g0 * oc[h][0] + g1 * os[h][0] + g2 * ow[h][0], r1 = g0 * oc[h][1] + g1 * os[h][1] + g2 * ow[h][1];
        *(GAS unsigned*)(OMIX + m * D + (g * 4 + h) * 128 + 2 * lane) = pk2(r0, r1); }
}

typedef short bf16x8v __attribute__((ext_vector_type(8)));
typedef short s16x4v __attribute__((ext_vector_type(4)));
typedef float f32x16 __attribute__((ext_vector_type(16)));
#define MFMA32(a, b, c) __builtin_amdgcn_mfma_f32_32x32x16_bf16((a), (b), (c), 0, 0, 0)
constexpr int KP = 272, VP = 136, VPC = 264;
constexpr int VR = 320;
constexpr int FL_K0 = 0, FL_V0 = 17408, FL_K1 = 37888, FL_V1 = 55296;
constexpr int CM_K = 0, CM_V = 34816;
constexpr int OA_MISC = 75776, OA_OT = 76800, OTP = 272;
__device__ __forceinline__ int crow(int reg, int hh) { return (reg & 3) + 8 * (reg >> 2) + 4 * hh; }
__device__ __forceinline__ bf16x8v pack8(float a0, float a1, float a2, float a3, float a4, float a5, float a6, float a7) {
    v4u q;
    asm volatile("s_nop 1\n\tv_cvt_pk_bf16_f32 %0, %4, %5\n\tv_cvt_pk_bf16_f32 %1, %6, %7\n\tv_cvt_pk_bf16_f32 %2, %8, %9\n\tv_cvt_pk_bf16_f32 %3, %10, %11\n\ts_nop 1"
                 : "=&v"(q[0]), "=&v"(q[1]), "=&v"(q[2]), "=&v"(q[3]) : "v"(a0), "v"(a1), "v"(a2), "v"(a3), "v"(a4), "v"(a5), "v"(a6), "v"(a7));
    return __builtin_bit_cast(bf16x8v, q);
}
__device__ __forceinline__ bf16x8v pack8m(float a0, float a1, float a2, float a3, float a4, float a5, float a6, float a7) {
    v4u q;
    asm volatile("s_nop 15\n\ts_nop 3\n\tv_cvt_pk_bf16_f32 %0, %4, %5\n\tv_cvt_pk_bf16_f32 %1, %6, %7\n\tv_cvt_pk_bf16_f32 %2, %8, %9\n\tv_cvt_pk_bf16_f32 %3, %10, %11\n\ts_nop 1"
                 : "=&v"(q[0]), "=&v"(q[1]), "=&v"(q[2]), "=&v"(q[3]) : "v"(a0), "v"(a1), "v"(a2), "v"(a3), "v"(a4), "v"(a5), "v"(a6), "v"(a7));
    return __builtin_bit_cast(bf16x8v, q);
}
struct TileRegs { v4u k0, k1, v0, v1; };
__device__ __forceinline__ void tile_load(TileRegs& R, const GAS bf16* Kg, const GAS bf16* Vg, int ld, int tid) {
    const int key = tid >> 4, c16 = tid & 15;
    R.k0 = *(const GAS v4u*)(Kg + (size_t)key * ld + c16 * 8);
    R.k1 = *(const GAS v4u*)(Kg + (size_t)(key + 32) * ld + c16 * 8);
    R.v0 = *(const GAS v4u*)(Vg + (size_t)(2 * key) * ld + c16 * 8);
    R.v1 = *(const GAS v4u*)(Vg + (size_t)(2 * key + 1) * ld + c16 * 8);
}
__device__ __forceinline__ void tile_store(const TileRegs& R, LAS unsigned char* Kb, LAS unsigned char* Vb, int vpitch, int vkeyoff, int tid) {
    const int key = tid >> 4, c16 = tid & 15;
    *(LAS v4u*)(Kb + key * KP + c16 * 16) = R.k0;
    *(LAS v4u*)(Kb + (key + 32) * KP + c16 * 16) = R.k1;
    LAS unsigned char* vb = Vb + (8 * c16) * vpitch + vkeyoff + key * 4;
    const unsigned a0 = R.v0.x, a1 = R.v0.y, a2 = R.v0.z, a3 = R.v0.w, b0 = R.v1.x, b1 = R.v1.y, b2 = R.v1.z, b3 = R.v1.w;
    *(LAS unsigned*)(vb + 0 * vpitch) = (a0 & 0xffffu) | (b0 << 16); *(LAS unsigned*)(vb + 1 * vpitch) = (a0 >> 16) | (b0 & 0xffff0000u);
    *(LAS unsigned*)(vb + 2 * vpitch) = (a1 & 0xffffu) | (b1 << 16); *(LAS unsigned*)(vb + 3 * vpitch) = (a1 >> 16) | (b1 & 0xffff0000u);
    *(LAS unsigned*)(vb + 4 * vpitch) = (a2 & 0xffffu) | (b2 << 16); *(LAS unsigned*)(vb + 5 * vpitch) = (a2 >> 16) | (b2 & 0xffff0000u);
    *(LAS unsigned*)(vb + 6 * vpitch) = (a3 & 0xffffu) | (b3 << 16); *(LAS unsigned*)(vb + 7 * vpitch) = (a3 >> 16) | (b3 & 0xffff0000u);
}
__device__ __forceinline__ void tile_store_rm(const TileRegs& R, LAS unsigned char* Kb, LAS unsigned char* Vb, int tid) {
    const int key = tid >> 4, c16 = tid & 15;
    *(LAS v4u*)(Kb + key * KP + c16 * 16) = R.k0;
    *(LAS v4u*)(Kb + (key + 32) * KP + c16 * 16) = R.k1;
    *(LAS v4u*)(Vb + (2 * key) * VR + c16 * 16) = R.v0;
    *(LAS v4u*)(Vb + (2 * key + 1) * VR + c16 * 16) = R.v1;
}
#define TRV_ISSUE_(A, va_, dt_) asm volatile( \
    "ds_read_b64_tr_b16 %0, %8 offset:%9\n\tds_read_b64_tr_b16 %1, %8 offset:%10\n\tds_read_b64_tr_b16 %2, %8 offset:%11\n\tds_read_b64_tr_b16 %3, %8 offset:%12\n\t" \
    "ds_read_b64_tr_b16 %4, %8 offset:%13\n\tds_read_b64_tr_b16 %5, %8 offset:%14\n\tds_read_b64_tr_b16 %6, %8 offset:%15\n\tds_read_b64_tr_b16 %7, %8 offset:%16" \
    : "=&v"(A[0]), "=&v"(A[1]), "=&v"(A[2]), "=&v"(A[3]), "=&v"(A[4]), "=&v"(A[5]), "=&v"(A[6]), "=&v"(A[7]) : "v"(va_), \
      "n"(64 * (dt_)), "n"(64 * (dt_) + 8 * VR), "n"(64 * (dt_) + 16 * VR), "n"(64 * (dt_) + 24 * VR), "n"(64 * (dt_) + 32 * VR), "n"(64 * (dt_) + 40 * VR), "n"(64 * (dt_) + 48 * VR), "n"(64 * (dt_) + 56 * VR) : "memory")
#define TRV_WAIT_(A, n_) asm volatile("s_waitcnt lgkmcnt(" #n_ ")" : "+v"(A[0]), "+v"(A[1]), "+v"(A[2]), "+v"(A[3]), "+v"(A[4]), "+v"(A[5]), "+v"(A[6]), "+v"(A[7]) :: "memory")
constexpr float QSC = 0.08838834764831845f;
constexpr float QSC2 = 0.08838834764831845f * 1.4426950408889634f;
template <int MODE>
__device__ __forceinline__ void flash_tile(const LAS unsigned char* Kb, const LAS unsigned char* Vb, const bf16x8v (&qf)[8], f32x16 (&o)[4], float& m, float& l,
                                           int kbase, int t, float slope2, bool selbit, bool edge, int r, int hh) {
    f32x16 S0, S1; const int lane_ = hh * 32 + r;
#pragma unroll
    for (int i = 0; i < 16; ++i) { S0[i] = 0.f; S1[i] = 0.f; }
    const LAS unsigned char* ka = Kb + r * KP + 16 * hh;
    bf16x8v kf[2][4];
#define LDK_(g, bu) { kf[bu][0] = *(const LAS bf16x8v*)(ka + 64 * (g)); kf[bu][1] = *(const LAS bf16x8v*)(ka + 32 * KP + 64 * (g)); kf[bu][2] = *(const LAS bf16x8v*)(ka + 64 * (g) + 32); kf[bu][3] = *(const LAS bf16x8v*)(ka + 32 * KP + 64 * (g) + 32); }
    LDK_(0, 0)
#pragma unroll
    for (int g = 0; g < 4; ++g) {
        if (g == 0) LDK_(1, 1) else if (g == 1) LDK_(2, 0) else if (g == 2) LDK_(3, 1)
        __builtin_amdgcn_sched_barrier(0);
        S0 = MFMA32(kf[g & 1][0], qf[2 * g], S0); S1 = MFMA32(kf[g & 1][1], qf[2 * g], S1); S0 = MFMA32(kf[g & 1][2], qf[2 * g + 1], S0); S1 = MFMA32(kf[g & 1][3], qf[2 * g + 1], S1);
        __builtin_amdgcn_sched_barrier(0);
    }
#undef LDK_
    const LAS unsigned char* va = Vb + (4 * hh + ((lane_ & 15) >> 2)) * VR + (16 * ((lane_ >> 4) & 1) + 4 * (lane_ & 3)) * 2;
    s16x4v vA[8], vB[8];
    TRV_ISSUE_(vA, va, 0);
    float mx = -1.0e30f;
    const int kb4 = kbase + 4 * hh;
    const float bias0 = (MODE == 0 && !selbit) ? -1.0e30f : slope2 * (float)(kb4 - t);
#pragma unroll
    for (int reg = 0; reg < 16; ++reg) { const int c = (reg & 3) + 8 * (reg >> 2);
        S0[reg] = fmaf(slope2, (float)c, fmaf(S0[reg], QSC2, bias0)); S1[reg] = fmaf(slope2, (float)(c + 32), fmaf(S1[reg], QSC2, bias0)); }
    if (edge) {
#pragma unroll
        for (int reg = 0; reg < 16; ++reg) { const int k0 = kb4 + (reg & 3) + 8 * (reg >> 2), k1 = k0 + 32; bool v0, v1;
            if (MODE == 0) { v0 = (k0 <= t); v1 = (k1 <= t); } else { v0 = (k0 <= t) && (t - k0 < 512); v1 = (k1 <= t) && (t - k1 < 512); }
            S0[reg] = v0 ? S0[reg] : -1.0e30f; S1[reg] = v1 ? S1[reg] : -1.0e30f; }
    }
#pragma unroll
    for (int reg = 0; reg < 16; ++reg) mx = fmaxf(mx, fmaxf(S0[reg], S1[reg]));
    mx = fmaxf(mx, __shfl_xor(mx, 32));
    const float mn = (mx > m + 8.0f) ? mx : m, alpha = __builtin_amdgcn_exp2f(m - mn); m = mn;
    float ps = 0.f;
#pragma unroll
    for (int reg = 0; reg < 16; ++reg) { S0[reg] = __builtin_amdgcn_exp2f(S0[reg] - mn); S1[reg] = __builtin_amdgcn_exp2f(S1[reg] - mn); ps += S0[reg] + S1[reg]; }
    l = l * alpha + ps;
    if (__any(alpha != 1.0f)) {
#pragma unroll
        for (int dt = 0; dt < 4; ++dt)
#pragma unroll
            for (int reg = 0; reg < 16; ++reg) o[dt][reg] *= alpha;
    }
    bf16x8v pf[4];
    pf[0] = pack8(S0[0], S0[1], S0[2], S0[3], S0[4], S0[5], S0[6], S0[7]); pf[1] = pack8(S0[8], S0[9], S0[10], S0[11], S0[12], S0[13], S0[14], S0[15]);
    pf[2] = pack8(S1[0], S1[1], S1[2], S1[3], S1[4], S1[5], S1[6], S1[7]); pf[3] = pack8(S1[8], S1[9], S1[10], S1[11], S1[12], S1[13], S1[14], S1[15]);
#define PV4_(A, dt_) { o[dt_] = MFMA32(__builtin_shufflevector(A[0], A[1], 0, 1, 2, 3, 4, 5, 6, 7), pf[0], o[dt_]); o[dt_] = MFMA32(__builtin_shufflevector(A[2], A[3], 0, 1, 2, 3, 4, 5, 6, 7), pf[1], o[dt_]); \
        o[dt_] = MFMA32(__builtin_shufflevector(A[4], A[5], 0, 1, 2, 3, 4, 5, 6, 7), pf[2], o[dt_]); o[dt_] = MFMA32(__builtin_shufflevector(A[6], A[7], 0, 1, 2, 3, 4, 5, 6, 7), pf[3], o[dt_]); }
    TRV_ISSUE_(vB, va, 1); TRV_WAIT_(vA, 8); PV4_(vA, 0)
    TRV_ISSUE_(vA, va, 2); TRV_WAIT_(vB, 8); PV4_(vB, 1)
    TRV_ISSUE_(vB, va, 3); TRV_WAIT_(vA, 8); PV4_(vA, 2)
    TRV_WAIT_(vB, 0); PV4_(vB, 3)
#undef PV4_
}
template <int MODE>
__device__ __forceinline__ void flash_branch(LAS unsigned char* lds, const GAS bf16* Kg0, const GAS bf16* Vg0, unsigned tiles, const bf16x8v (&qf)[8], f32x16 (&o)[4], float& l_out,
                                             int t, float slope2, unsigned mask, int r, int hh, int tid, int tq) {
#pragma unroll
    for (int dt = 0; dt < 4; ++dt)
#pragma unroll
        for (int i = 0; i < 16; ++i) o[dt][i] = 0.f;
    float m = -1.0e20f, l = 0.f;
    unsigned rem = (unsigned)__builtin_amdgcn_readfirstlane((int)tiles);
#define POP_TILE() (rem ? (31 - __builtin_clz(rem)) : -1)
    int k0 = POP_TILE(); rem &= ~(1u << k0);
    int k1 = POP_TILE(); if (k1 >= 0) rem &= ~(1u << k1);
    TileRegs RA;
    tile_load(RA, Kg0 + (size_t)k0 * 64 * ZO, Vg0 + (size_t)k0 * 64 * ZO, ZO, tid); tile_store_rm(RA, lds + FL_K0, lds + FL_V0, tid);
    if (k1 >= 0) tile_load(RA, Kg0 + (size_t)k1 * 64 * ZO, Vg0 + (size_t)k1 * 64 * ZO, ZO, tid);
    __syncthreads();
    int par = 0;
    for (;;) {
        { const bool edge = (k0 == tq) || (MODE == 1 && k0 == tq - 8);
          const bool selb = ((mask >> k0) & 1u) != 0u;
          if (MODE == 1 || __any(selb)) flash_tile<MODE>(lds + (par ? FL_K1 : FL_K0), lds + (par ? FL_V1 : FL_V0), qf, o, m, l, k0 * 64, t, slope2, selb, edge, r, hh); }
        if (k1 < 0) break;
        tile_store_rm(RA, lds + (par ? FL_K0 : FL_K1), lds + (par ? FL_V0 : FL_V1), tid);
        __syncthreads();
        const int k2 = POP_TILE(); if (k2 >= 0) rem &= ~(1u << k2);
        if (k2 >= 0) tile_load(RA, Kg0 + (size_t)k2 * 64 * ZO, Vg0 + (size_t)k2 * 64 * ZO, ZO, tid);
        k0 = k1; k1 = k2; par ^= 1;
    }
    __syncthreads();
    l_out = l + __shfl_xor(l, 32);
}
__device__ __forceinline__ void oatt_fast(const Params& p0, LAS unsigned char* lds, int b, int g, int tq) {
    PHASE_IDS(); Params p = p0; asm volatile("" : "+s"(p.ws)); GLOBAL_PARAMS(p);
    const int r = lane & 31, hh = lane >> 5, tl = r & 7, h = r >> 3;
    const int t = tq * 64 + wave * 8 + tl;
    const GAS bf16* Z = (const GAS bf16*)(p.ws + WS_Z); const GAS bf16* CMP = (const GAS bf16*)(p.ws + WS_CMP); const GAS float* gates = (const GAS float*)(p.ws + WS_GATES); GAS bf16* OMIX = (GAS bf16*)(p.ws + WS_OMIX);
    const size_t m = (size_t)b * T + t;
    const float slope = exp2f(-0.5f * (float)(g * 4 + h + 1));
    bf16x8v qf[8];
    { const GAS bf16* qrow = Z + m * ZO + (g * 4 + h) * 128 + 8 * hh;
#pragma unroll
      for (int s = 0; s < 8; ++s) qf[s] = *(const GAS bf16x8v*)(qrow + 16 * s); }
    LAS unsigned* misc = (LAS unsigned*)(lds + OA_MISC);
    if (tid == 0) misc[0] = 0u;
    { const GAS bf16* CK = CMP + ((size_t)((0 * 4 + b) * 4 + g) * 128) * 128; const GAS bf16* CV = CMP + ((size_t)((1 * 4 + b) * 4 + g) * 128) * 128;
      TileRegs R;
      tile_load(R, CK, CV, 128, tid); tile_store(R, lds + CM_K, lds + CM_V, VPC, 0, tid);
      tile_load(R, CK + 64 * 128, CV + 64 * 128, 128, tid); tile_store(R, lds + CM_K + 64 * KP, lds + CM_V, VPC, 128, tid); }
    __syncthreads();
    f32x16 S[4];
#pragma unroll
    for (int sub = 0; sub < 4; ++sub)
#pragma unroll
        for (int i = 0; i < 16; ++i) S[sub][i] = 0.f;
    { const LAS unsigned char* ka = lds + CM_K + r * KP + 16 * hh; bf16x8v kf[2][4];
#define LDC_(s_, bu) { _Pragma("unroll") for (int sub = 0; sub < 4; ++sub) kf[bu][sub] = *(const LAS bf16x8v*)(ka + sub * 32 * KP + 32 * (s_)); }
      LDC_(0, 0)
#pragma unroll
      for (int s = 0; s < 8; ++s) {
          if (s < 7) { if (s & 1) LDC_(s + 1, 0) else LDC_(s + 1, 1) }
          __builtin_amdgcn_sched_barrier(0);
#pragma unroll
          for (int sub = 0; sub < 4; ++sub) S[sub] = MFMA32(kf[s & 1][sub], qf[s], S[sub]);
          __builtin_amdgcn_sched_barrier(0); }
#undef LDC_
    }
    const int ncv = t >= 31 ? ((t - 31) >> 4) + 1 : 0;
    { float mx = -1.0e30f;
#pragma unroll
      for (int sub = 0; sub < 4; ++sub)
#pragma unroll
          for (int reg = 0; reg < 16; ++reg) { const int j = 32 * sub + crow(reg, hh); const float s = S[sub][reg] * QSC + slope * (float)(16 * j + 31 - t);
              S[sub][reg] = (j < ncv) ? s : -1.0e30f; mx = fmaxf(mx, S[sub][reg]); }
      mx = fmaxf(mx, __shfl_xor(mx, 32));
      float ps = 0.f;
#pragma unroll
      for (int sub = 0; sub < 4; ++sub)
#pragma unroll
          for (int reg = 0; reg < 16; ++reg) { const int j = 32 * sub + crow(reg, hh); const float e = (j < ncv) ? __expf(S[sub][reg] - mx) : 0.f; S[sub][reg] = e; ps += e; }
      ps += __shfl_xor(ps, 32);
      const float inv = ps > 0.f ? __builtin_amdgcn_rcpf(ps) : 0.f;
#pragma unroll
      for (int sub = 0; sub < 4; ++sub)
#pragma unroll
          for (int reg = 0; reg < 16; ++reg) S[sub][reg] *= inv; }
    float imp[16];
    { float prevLo = 0.f;
#pragma unroll
      for (int qq = 0; qq < 16; ++qq) { const int sub = qq >> 2, rq = qq & 3;
          const float A = (S[sub][4 * rq] + S[sub][4 * rq + 1]) + (S[sub][4 * rq + 2] + S[sub][4 * rq + 3]); const float Lq = S[sub][4 * rq + 3];
          const float Lo = __shfl_xor(Lq, 32);
          imp[qq] = A + (hh ? Lo : prevLo); prevLo = Lo; }
#pragma unroll
      for (int qq = 0; qq < 16; ++qq) { imp[qq] += __shfl_xor(imp[qq], 8); imp[qq] += __shfl_xor(imp[qq], 16); } }
    f32x16 o[4];
#pragma unroll
    for (int dt = 0; dt < 4; ++dt)
#pragma unroll
        for (int i = 0; i < 16; ++i) o[dt][i] = 0.f;
    { bf16x8v pf[8];
#pragma unroll
      for (int s2 = 0; s2 < 8; ++s2) { const int sub = s2 >> 1, b8 = 8 * (s2 & 1);
          pf[s2] = pack8(S[sub][b8], S[sub][b8 + 1], S[sub][b8 + 2], S[sub][b8 + 3], S[sub][b8 + 4], S[sub][b8 + 5], S[sub][b8 + 6], S[sub][b8 + 7]); }
      const LAS unsigned char* va = lds + CM_V + r * VPC + 8 * hh; bf16x8v vf[2][4];
#define LDCV_(g_, bu) { _Pragma("unroll") for (int j = 0; j < 4; ++j) { const int dt_ = (g_) >> 1, s2_ = 4 * ((g_) & 1) + j; const s16x4v lo = *(const LAS s16x4v*)(va + dt_ * 32 * VPC + 32 * s2_), hi = *(const LAS s16x4v*)(va + dt_ * 32 * VPC + 32 * s2_ + 16); vf[bu][j] = __builtin_shufflevector(lo, hi, 0, 1, 2, 3, 4, 5, 6, 7); } }
      LDCV_(0, 0)
#pragma unroll
      for (int g = 0; g < 8; ++g) {
          if (g < 7) { if (g & 1) LDCV_(g + 1, 0) else LDCV_(g + 1, 1) }
          __builtin_amdgcn_sched_barrier(0);
#pragma unroll
          for (int j = 0; j < 4; ++j) o[g >> 1] = MFMA32(vf[g & 1][j], pf[4 * (g & 1) + j], o[g >> 1]);
          __builtin_amdgcn_sched_barrier(0); }
#undef LDCV_
    }
    const GAS float* gl = gates + m * 64 + g * 12 + h * 3;
    const float g0 = sigmoid_f(gl[0]), g1 = sigmoid_f(gl[1]), g2 = sigmoid_f(gl[2]);
    LAS unsigned char* orow = lds + OA_OT + (wave * 32 + r) * OTP + 8 * hh;
#pragma unroll
    for (int dt = 0; dt < 4; ++dt)
#pragma unroll
        for (int q4 = 0; q4 < 4; ++q4) { v2u w; w.x = pk2(g0 * o[dt][4 * q4], g0 * o[dt][4 * q4 + 1]); w.y = pk2(g0 * o[dt][4 * q4 + 2], g0 * o[dt][4 * q4 + 3]); *(LAS v2u*)(orow + (32 * dt + 8 * q4) * 2) = w; }
    unsigned mask;
    if (tq <= 7) mask = (2u << tq) - 1u;
    else {
        float sc[32];
#pragma unroll
        for (int qq = 0; qq < 16; ++qq) { const float oth = __shfl_xor(imp[qq], 32); sc[2 * qq] = hh ? oth : imp[qq]; sc[2 * qq + 1] = hh ? imp[qq] : oth; }
#pragma unroll
        for (int i = 0; i < 32; ++i) { const bool forced = (i == 0) || (i == tq) || (i == tq - 1); sc[i] = forced ? 1.0e4f : (i > tq ? -1.0e4f : sc[i]); }
        int key[32];
#pragma unroll
        for (int i = 0; i < 32; ++i) key[i] = (__builtin_bit_cast(int, sc[i]) & ~31) | (31 - i);
        const int c8 = h * 2 + hh; unsigned part = 0u;
#pragma unroll
        for (int k = 0; k < 4; ++k) { int own = key[k];
#pragma unroll
            for (int cc = 1; cc < 8; ++cc) own = (c8 == cc) ? key[4 * cc + k] : own;
            int cnt = 0;
#pragma unroll
            for (int i2 = 0; i2 < 32; ++i2) cnt += (key[i2] > own) ? 1 : 0;
            const int idx = 4 * c8 + k; if (cnt < 8 && idx <= tq) part |= (1u << idx); }
        part |= (unsigned)__shfl_xor((int)part, 8); part |= (unsigned)__shfl_xor((int)part, 16); part |= (unsigned)__shfl_xor((int)part, 32);
        mask = part;
    }
    { unsigned um = mask; um |= __shfl_xor(um, 1); um |= __shfl_xor(um, 2); um |= __shfl_xor(um, 4); if (lane == 0) atomicOr((unsigned*)misc, um); }
    __syncthreads();
    const unsigned uni = misc[0];
    const unsigned upto = (tq >= 31) ? 0xffffffffu : ((2u << tq) - 1u);
    { float lsum; const GAS bf16* Kg0 = Z + (size_t)b * T * ZO + 3072 + g * 128; const GAS bf16* Vg0 = Z + (size_t)b * T * ZO + 3584 + g * 128;
#ifdef OATT_RP_SEL
      flash_branch<0>(lds, Kg0, Vg0, uni & upto, qf, o, lsum, t, slope * 1.4426950408889634f, mask, r, hh, tid, tq);
      if (lsum == -1.0f) misc[3] = __builtin_bit_cast(unsigned, o[0][0] + o[1][0] + o[2][0] + o[3][0]);
#endif
      flash_branch<0>(lds, Kg0, Vg0, uni & upto, qf, o, lsum, t, slope * 1.4426950408889634f, mask, r, hh, tid, tq);
      const float sc1 = g1 * __builtin_amdgcn_rcpf(lsum); v2u ow_[16];
#pragma unroll
      for (int dt = 0; dt < 4; ++dt)
#pragma unroll
          for (int q4 = 0; q4 < 4; ++q4) ow_[4 * dt + q4] = *(const LAS v2u*)(orow + (32 * dt + 8 * q4) * 2);
      __builtin_amdgcn_sched_barrier(0);
#pragma unroll
      for (int dt = 0; dt < 4; ++dt)
#pragma unroll
          for (int q4 = 0; q4 < 4; ++q4) { v2u w = ow_[4 * dt + q4];
              w.x = pk2(bflo(w.x) + sc1 * o[dt][4 * q4], bfhi(w.x) + sc1 * o[dt][4 * q4 + 1]); w.y = pk2(bflo(w.y) + sc1 * o[dt][4 * q4 + 2], bfhi(w.y) + sc1 * o[dt][4 * q4 + 3]);
              *(LAS v2u*)(orow + (32 * dt + 8 * q4) * 2) = w; } }
    { float lsum; const GAS bf16* Kg0 = Z + (size_t)b * T * ZO + 4096 + g * 128; const GAS bf16* Vg0 = Z + (size_t)b * T * ZO + 4608 + g * 128;
      const int klo = tq > 8 ? tq - 8 : 0; const unsigned wt = upto & ~((1u << klo) - 1u);
#ifdef OATT_RP_WIN
      flash_branch<1>(lds, Kg0, Vg0, wt, qf, o, lsum, t, slope * 1.4426950408889634f, 0u, r, hh, tid, tq);
      if (lsum == -1.0f) misc[3] = __builtin_bit_cast(unsigned, o[0][0] + o[1][0] + o[2][0] + o[3][0]);
#endif
      flash_branch<1>(lds, Kg0, Vg0, wt, qf, o, lsum, t, slope * 1.4426950408889634f, 0u, r, hh, tid, tq);
      const float sc2 = g2 * __builtin_amdgcn_rcpf(lsum); v2u ow_[16];
#pragma unroll
      for (int dt = 0; dt < 4; ++dt)
#pragma unroll
          for (int q4 = 0; q4 < 4; ++q4) ow_[4 * dt + q4] = *(const LAS v2u*)(orow + (32 * dt + 8 * q4) * 2);
      __builtin_amdgcn_sched_barrier(0);
#pragma unroll
      for (int dt = 0; dt < 4; ++dt)
#pragma unroll
          for (int q4 = 0; q4 < 4; ++q4) { v2u w = ow_[4 * dt + q4];
              w.x = pk2(bflo(w.x) + sc2 * o[dt][4 * q4], bfhi(w.x) + sc2 * o[dt][4 * q4 + 1]); w.y = pk2(bflo(w.y) + sc2 * o[dt][4 * q4 + 2], bfhi(w.y) + sc2 * o[dt][4 * q4 + 3]);
              *(LAS v2u*)(orow + (32 * dt + 8 * q4) * 2) = w; } }
    LDS_WAIT();
    { const int c16 = lane & 15, rsub = lane >> 4;
#pragma unroll
      for (int k = 0; k < 8; ++k) { const int rr = 4 * k + rsub, hr = rr >> 3, tr = rr & 7;
          const v4u w = *(const LAS v4u*)(lds + OA_OT + (wave * 32 + rr) * OTP + c16 * 16 - 0);
          *(GAS v4u*)(OMIX + ((size_t)b * T + tq * 64 + wave * 8 + tr) * D + (g * 4 + hr) * 128 + c16 * 8) = w; } }
    __syncthreads();
}

constexpr size_t WS_HREC = 752 * MiB; constexpr int HREC = 33024, H_QH = 0, H_KHT = 8192, H_VHT = 16384, H_OI = 24576, H_DE = 32768;
constexpr size_t WS_GREC = 834 * MiB; constexpr int GREC = 45056, G_NW = 0, G_QG = 8192, G_KGT = 16384, G_QKG = 24576, G_UU = 28672;
constexpr size_t WS_GEND = 922 * MiB;
constexpr size_t WS_OA = 924 * MiB;
__device__ __forceinline__ bf16x8v frag_nat(const LAS unsigned char* img, int row, int pitch, int k0, int hh) { return *(const LAS bf16x8v*)(img + row * pitch + (k0 + 8 * hh) * 2); }
__device__ __forceinline__ bf16x8v frag_perm(const LAS unsigned char* img, int row, int pitch, int k0, int hh) {
    const s16x4v lo = *(const LAS s16x4v*)(img + row * pitch + (k0 + 4 * hh) * 2), hi = *(const LAS s16x4v*)(img + row * pitch + (k0 + 8 + 4 * hh) * 2);
    return __builtin_shufflevector(lo, hi, 0, 1, 2, 3, 4, 5, 6, 7);
}
__device__ __forceinline__ f32x16 zero16() { f32x16 z;
#pragma unroll
    for (int i = 0; i < 16; ++i) z[i] = 0.f;
    return z; }
#define PACK_STEP(X, s) pack8m((X)[8 * (s)], (X)[8 * (s) + 1], (X)[8 * (s) + 2], (X)[8 * (s) + 3], (X)[8 * (s) + 4], (X)[8 * (s) + 5], (X)[8 * (s) + 6], (X)[8 * (s) + 7])
#define PACK_STEP_L(X, s) pack8((X)[8 * (s)], (X)[8 * (s) + 1], (X)[8 * (s) + 2], (X)[8 * (s) + 3], (X)[8 * (s) + 4], (X)[8 * (s) + 5], (X)[8 * (s) + 6], (X)[8 * (s) + 7])

constexpr int GA_IK = 0, GA_IQ = 17408, GA_IV = 34816, GA_SL = 67584, GA_SG = 84992;
constexpr int GA_AU = 86016, GA_AW = 95232, GA_T00 = 104448, GA_T11 = 107008, GA_L10 = 109568;
__device__ __forceinline__ const LAS unsigned char* tr_addr(const LAS unsigned char* img, int pitch, int n0, int lane) {
    return img + (8 * (lane >> 5) + ((lane & 15) >> 2)) * pitch + (n0 + 16 * ((lane >> 4) & 1) + 4 * (lane & 3)) * 2;
}
template <int PITCH> __device__ __forceinline__ bf16x8v tr_frag(const LAS unsigned char* a) {
    s16x4v lo, hi;
    asm volatile("ds_read_b64_tr_b16 %0, %2\n\tds_read_b64_tr_b16 %1, %2 offset:%3\n\ts_waitcnt lgkmcnt(0)" : "=&v"(lo), "=&v"(hi) : "v"(a), "n"(4 * PITCH) : "memory");
    return __builtin_shufflevector(lo, hi, 0, 1, 2, 3, 4, 5, 6, 7);
}
__device__ __forceinline__ void gdn_tinv(LAS unsigned char* lds, int lane) {
    LAS unsigned char* bL = lds + GA_SL; LAS unsigned char* bG = lds + GA_SG; LAS unsigned char* bA = lds + GA_AU;
    asm volatile("" : "+v"(bL), "+v"(bG), "+v"(bA));
    const int blk = lane >> 5, c = lane & 31, r = lane & 31, hh = lane >> 5;
    const LAS unsigned char* pL = bL + (32 * blk * 68 + 32 * blk) * 4;
    float x[32];
#pragma unroll
    for (int i = 0; i < 32; ++i) {
        if (i > 2) asm volatile("" : "+v"(pL) : "v"(x[i > 2 ? i - 3 : 0]));
        const LAS float* sL = (const LAS float*)pL;
        float a = (i == c) ? 1.f : 0.f, a1 = 0.f, a2 = 0.f, a3 = 0.f;
#pragma unroll
        for (int j4 = 0; j4 < (i + 3) / 4; ++j4) { const f32x4 l4 = *(const LAS f32x4*)(sL + i * 68 + 4 * j4);
            if (4 * j4 + 0 < i) a -= l4[0] * x[4 * j4 + 0]; if (4 * j4 + 1 < i) a1 -= l4[1] * x[4 * j4 + 1]; if (4 * j4 + 2 < i) a2 -= l4[2] * x[4 * j4 + 2]; if (4 * j4 + 3 < i) a3 -= l4[3] * x[4 * j4 + 3]; }
        x[i] = (a + a1) + (a2 + a3);
    }
    const LAS float* sG = (const LAS float*)bG; const float su = sG[64 + lane], sw = -su * sG[128 + lane];
    { LAS unsigned char* tI = bA + (GA_T00 - GA_AU) + blk * 2560 + c * 2; LAS unsigned char* aU = bA + (32 * blk) * 144 + lane * 2; LAS unsigned char* aW = aU + (GA_AW - GA_AU);
#pragma unroll
      for (int i = 0; i < 32; ++i) { const unsigned w1 = pk2(x[i], x[i] * su), w2 = pk2(x[i] * sw, 0.f);
          *(LAS bf16*)(tI + i * 80) = (bf16)(w1 & 0xffffu); *(LAS bf16*)(aU + i * 144) = (bf16)(w1 >> 16); *(LAS bf16*)(aW + i * 144) = (bf16)(w2 & 0xffffu); } }
    LDS_WAIT();
    f32x16 P = zero16();
    { const LAS unsigned char* tb = tr_addr(bA + (GA_T00 - GA_AU), 80, 0, lane);
#pragma unroll
      for (int s2 = 0; s2 < 2; ++s2) { const bf16x8v a = frag_nat(bA + (GA_L10 - GA_AU), r, 80, 16 * s2, hh), bb = tr_frag<80>(tb + 16 * s2 * 80); P = MFMA32(a, bb, P); } }
    f32x16 Q = zero16();
#pragma unroll
    for (int s2 = 0; s2 < 2; ++s2) { const bf16x8v a = frag_perm(bA + (GA_T11 - GA_AU), r, 80, 16 * s2, hh), bb = PACK_STEP(P, s2); Q = MFMA32(a, bb, Q); }
    const float su0 = sG[64 + r], sw0 = su0 * sG[128 + r];
#pragma unroll
    for (int reg = 0; reg < 16; ++reg) { LAS unsigned char* aU = bA + (32 + crow(reg, hh)) * 144 + r * 2;
        const float qa_ = -Q[reg] * su0, qb_ = Q[reg] * sw0; const unsigned w3 = pk2(qa_, qb_);
        *(LAS bf16*)aU = (bf16)(w3 & 0xffffu); *(LAS bf16*)(aU + (GA_AW - GA_AU)) = (bf16)(w3 >> 16); }
}
__device__ __forceinline__ void gdn_apply(const LAS unsigned char* lds, int mat, int ct, int lane, GAS bf16* out) {
    const LAS unsigned char* bA = lds + GA_AU; asm volatile("" : "+v"(bA));
    const int r = lane & 31, hh = lane >> 5;
    const LAS unsigned char* img = bA + (mat ? GA_IK - GA_AU : GA_IV - GA_AU); const LAS unsigned char* A = bA + (mat ? GA_AW - GA_AU : 0);
    const LAS unsigned char* tb = tr_addr(img, 272, 32 * ct, lane);
    f32x16 X0 = zero16(), X1 = zero16();
    bf16x8v a0_[2], a1_[4], bb[4];
#pragma unroll
    for (int s4 = 0; s4 < 4; ++s4) { if (s4 < 2) a0_[s4] = frag_nat(A, r, 144, 16 * s4, hh); a1_[s4] = frag_nat(A, 32 + r, 144, 16 * s4, hh); }
    { s16x4v l0, h0, l1, h1, l2, h2, l3, h3;
      asm volatile("ds_read_b64_tr_b16 %0, %8\n\tds_read_b64_tr_b16 %1, %8 offset:1088\n\tds_read_b64_tr_b16 %2, %8 offset:4352\n\tds_read_b64_tr_b16 %3, %8 offset:5440\n\t"
                   "ds_read_b64_tr_b16 %4, %8 offset:8704\n\tds_read_b64_tr_b16 %5, %8 offset:9792\n\tds_read_b64_tr_b16 %6, %8 offset:13056\n\tds_read_b64_tr_b16 %7, %8 offset:14144\n\ts_waitcnt lgkmcnt(0)"
                   : "=&v"(l0), "=&v"(h0), "=&v"(l1), "=&v"(h1), "=&v"(l2), "=&v"(h2), "=&v"(l3), "=&v"(h3) : "v"(tb) : "memory");
      bb[0] = __builtin_shufflevector(l0, h0, 0, 1, 2, 3, 4, 5, 6, 7); bb[1] = __builtin_shufflevector(l1, h1, 0, 1, 2, 3, 4, 5, 6, 7);
      bb[2] = __builtin_shufflevector(l2, h2, 0, 1, 2, 3, 4, 5, 6, 7); bb[3] = __builtin_shufflevector(l3, h3, 0, 1, 2, 3, 4, 5, 6, 7); }
#pragma unroll
    for (int s4 = 0; s4 < 4; ++s4) { if (s4 < 2) X0 = MFMA32(a0_[s4], bb[s4], X0); X1 = MFMA32(a1_[s4], bb[s4], X1); }
    GAS bf16* o = out + 32 * ct + r;
#pragma unroll
    for (int reg = 0; reg < 16; ++reg) { o[crow(reg, hh) * 128] = (bf16)f2bf(X0[reg]); o[(32 + crow(reg, hh)) * 128] = (bf16)f2bf(X1[reg]); }
}
__device__ __forceinline__ void ea_gdn(const Params& p0, LAS unsigned char* lds, int ch, int je) {
    PHASE_IDS(); Params p = p0; asm volatile("" : "+s"(p.ws)); GLOBAL_PARAMS(p);
    const int n = ch & 31, h = (ch >> 5) & 7, b = ch >> 8, t0 = n * 64, r = lane & 31, hh = lane >> 5;
    const GAS bf16* Z = (const GAS bf16*)(p.ws + WS_Z); const GAS float* gates = (const GAS float*)(p.ws + WS_GATES);
    LAS float* sL = (LAS float*)(lds + GA_SL); LAS float* sG = (LAS float*)(lds + GA_SG); LAS float* sBeta = sG + 64; LAS float* sEg = sG + 128; LAS float* sLd = sG + 192;
    if (tid < 384) {
        const int cc = tid % 48, tg = tid / 48, which = cc >> 4, c8 = (cc & 15) * 8;
        const int zcol = 4096 + which * 1024 + h * 128 + c8, wcol = which * 1024 + h * 128 + c8;
        v4u zin[11];
#pragma unroll
        for (int i = 0; i < 11; ++i) { const int tpos = t0 + tg * 8 - 3 + i; zin[i] = (tpos >= 0) ? *(const GAS v4u*)(Z + ((size_t)b * T + (tpos >= 0 ? tpos : 0)) * ZE + zcol) : (v4u){0u, 0u, 0u, 0u}; }
        f32x4 wA[4], wB[4];
#pragma unroll
        for (int kk = 0; kk < 4; ++kk) { const GAS float* cw = p.conv_w + ((size_t)(je * 4 + kk)) * 3072 + wcol; wA[kk] = *(const GAS f32x4*)cw; wB[kk] = *(const GAS f32x4*)(cw + 4); }
#pragma unroll
        for (int t8 = 0; t8 < 8; ++t8) { const int tt = tg * 8 + t8; float acc[8];
#pragma unroll
            for (int i = 0; i < 8; ++i) acc[i] = 0.f;
#pragma unroll
            for (int kk = 0; kk < 4; ++kk) { const v4u zw = zin[t8 + kk];
                acc[0] += wA[kk][0] * bflo(zw.x); acc[1] += wA[kk][1] * bfhi(zw.x); acc[2] += wA[kk][2] * bflo(zw.y); acc[3] += wA[kk][3] * bfhi(zw.y);
                acc[4] += wB[kk][0] * bflo(zw.z); acc[5] += wB[kk][1] * bfhi(zw.z); acc[6] += wB[kk][2] * bflo(zw.w); acc[7] += wB[kk][3] * bfhi(zw.w); }
            float ss = 0.f;
#pragma unroll
            for (int i = 0; i < 8; ++i) { acc[i] = silu2_f(acc[i]); ss += acc[i] * acc[i]; }
            ss = row16_sum(ss);
            { const float sc = which < 2 ? __builtin_amdgcn_rsqf(ss + 1e-6f) * (which == 0 ? 0.08838834764831845f : 1.0f) : 1.0f;
                v4u w; w.x = pk2(acc[0] * sc, acc[1] * sc); w.y = pk2(acc[2] * sc, acc[3] * sc); w.z = pk2(acc[4] * sc, acc[5] * sc); w.w = pk2(acc[6] * sc, acc[7] * sc);
                *(LAS v4u*)(lds + (which == 0 ? GA_IQ : which == 1 ? GA_IK : GA_IV) + tt * 272 + c8 * 2) = w; }
        }
    }
    if (tid >= 384 && tid < 448) { const int tk = tid - 384; const size_t m = (size_t)b * T + t0 + tk; const float ba = gates[m * 64 + h], bb = gates[m * 64 + 8 + h];
        const float xx = ba + p.dt_bias[je * 8 + h]; const float sp = xx > 20.f ? xx : __logf(1.0f + __expf(xx));
        float v = -__expf(p.a_log[je * 8 + h]) * sp; sBeta[tk] = sigmoid_f(bb);
#pragma unroll
        for (int o = 1; o < 64; o <<= 1) { const float x = __shfl_up(v, o); if (tk >= o) v += x; }
        sG[tk] = v; sEg[tk] = __expf(v); }
    __syncthreads();
    { const int mat = wave >> 2, ti = (wave >> 1) & 1, tj = wave & 1;
      const LAS unsigned char* imgA = lds + (mat ? GA_IQ : GA_IK); f32x16 acc = zero16(); bf16x8v fa_[8], fb_[8];
#pragma unroll
      for (int s = 0; s < 8; ++s) { fa_[s] = frag_nat(imgA, 32 * ti + r, 272, 16 * s, hh); fb_[s] = frag_nat(lds + GA_IK, 32 * tj + r, 272, 16 * s, hh); }
      __builtin_amdgcn_sched_barrier(0);
#pragma unroll
      for (int s = 0; s < 8; ++s) acc = MFMA32(fa_[s], fb_[s], acc);
      const int sc_ = 32 * tj + r; const float gs = sG[sc_];
      GAS bf16* QKG = (GAS bf16*)(p.ws + WS_GREC) + (size_t)ch * GREC + G_QKG;
#pragma unroll
      for (int reg = 0; reg < 16; ++reg) { const int tt = 32 * ti + crow(reg, hh); const float val = acc[reg] * __expf(sG[tt] - gs);
          if (mat == 0) { const float lv = (sc_ < tt) ? sBeta[tt] * val : 0.f; sL[tt * 68 + sc_] = lv; if (ti == 1 && tj == 0) *(LAS bf16*)(lds + GA_L10 + (tt - 32) * 80 + sc_ * 2) = (bf16)(pk2(lv, 0.f) & 0xffffu); }
          else QKG[tt * 64 + sc_] = (bf16)(pk2((sc_ <= tt) ? val : 0.f, 0.f) & 0xffffu); } }
    __syncthreads();
    if (wave == 0) gdn_tinv(lds, lane);
    else if (wave < 4) { }
    else {
        const int ht = tid - 256; const float gend = sG[63];
        GAS bf16* QG = (GAS bf16*)(p.ws + WS_GREC) + (size_t)ch * GREC + G_QG;
#pragma unroll
        for (int k = 0; k < 4; ++k) { const int cidx = ht + 256 * k, tt = cidx >> 4, c16 = cidx & 15; const float e = sEg[tt];
            const v4u w = *(const LAS v4u*)(lds + GA_IQ + tt * 272 + c16 * 16); v4u o;
            o.x = pk2(bflo(w.x) * e, bfhi(w.x) * e); o.y = pk2(bflo(w.y) * e, bfhi(w.y) * e); o.z = pk2(bflo(w.z) * e, bfhi(w.z) * e); o.w = pk2(bflo(w.w) * e, bfhi(w.w) * e);
            *(GAS v4u*)(QG + tt * 128 + c16 * 8) = o; }
        { const int d = ht & 127, tp = ht >> 7; GAS bf16* KGT = (GAS bf16*)(p.ws + WS_GREC) + (size_t)ch * GREC + G_KGT + d * 64 + 32 * tp;
#pragma unroll
          for (int q8 = 0; q8 < 4; ++q8) { float v[8], gz_[8]; unsigned short kz_[8];
#pragma unroll
              for (int i = 0; i < 8; ++i) { const int tt = 32 * tp + 8 * q8 + i; kz_[i] = *(const LAS unsigned short*)(lds + GA_IK + tt * 272 + d * 2); gz_[i] = sG[tt]; }
              __builtin_amdgcn_sched_barrier(0);
#pragma unroll
              for (int i = 0; i < 8; ++i) v[i] = bflo((unsigned)kz_[i]) * __expf(gend - gz_[i]);
              v4u o; o.x = pk2(v[0], v[1]); o.y = pk2(v[2], v[3]); o.z = pk2(v[4], v[5]); o.w = pk2(v[6], v[7]); *(GAS v4u*)(KGT + 8 * q8) = o; } }
        if (ht == 0) ((GAS float*)(p.ws + WS_GEND))[ch] = __expf(gend);
    }
    __syncthreads();
    gdn_apply(lds, wave >> 2, wave & 3, lane, (GAS bf16*)(p.ws + WS_GREC) + (size_t)ch * GREC + (wave >> 2 ? G_NW : G_UU));
    __syncthreads();
}

constexpr int HA_IQ = 0, HA_IK0 = 17408, HA_IK1 = 26112, HA_IVT = 43520, HA_IIN = 61952, HA_TOT = 71168;
__device__ __forceinline__ void ea_hgrn(const Params& p0, LAS unsigned char* lds, int ch, int je) {
    PHASE_IDS(); Params p = p0; asm volatile("" : "+s"(p.ws)); GLOBAL_PARAMS(p);
    const int n = ch & 31, h = (ch >> 5) & 7, b = ch >> 8, t0 = n * 64, r = lane & 31, hh = lane >> 5;
    const GAS bf16* Z = (const GAS bf16*)(p.ws + WS_Z);
    LAS float* sTot = (LAS float*)(lds + HA_TOT);
    const int d = tid & 127, part = tid >> 7;
    float q[16], kk[16], v[16], bcs[16];
    { const int chn = h * 128 + d; const float lb = je ? sigmoid_f(p.hgrn_lb[1024 + chn] - p.hgrn_lb[chn]) : 0.f; float run = 0.f; bf16 zq[16], zf[16], zv[16];
#pragma unroll
      for (int i = 0; i < 16; ++i) { const size_t m = (size_t)b * T + t0 + 16 * part + i; const GAS bf16* zr = Z + m * ZE + chn; zq[i] = zr[0]; zf[i] = zr[1024]; zv[i] = zr[2048]; }
      __builtin_amdgcn_sched_barrier(0);
#pragma unroll
      for (int i = 0; i < 16; ++i) { q[i] = bflo((unsigned)zq[i]); const float fl = bflo((unsigned)zf[i]); v[i] = bflo((unsigned)zv[i]);
          const float f = lb + (1.0f - lb) * sigmoid_f(fl); kk[i] = 1.0f - f; run += __logf(f); bcs[i] = run; }
      sTot[part * 128 + d] = run; }
    __syncthreads();
    const float tot0 = sTot[d], tot1 = sTot[128 + d], tot2 = sTot[256 + d], tot3 = sTot[384 + d];
    const float off = (part > 0 ? tot0 : 0.f) + (part > 1 ? tot1 : 0.f) + (part > 2 ? tot2 : 0.f);
    const float b31 = tot0 + tot1, bend = (tot0 + tot1) + (tot2 + tot3), ref = (part >= 2) ? b31 : 0.f;
    {
        GAS bf16* QH = (GAS bf16*)(p.ws + WS_HREC) + (size_t)ch * HREC + H_QH + d; float kh[16];
#pragma unroll
        for (int i = 0; i < 16; ++i) { const int tt = 16 * part + i; const float bt = bcs[i] + off;
            const unsigned wq_ = pk2(q[i] * __expf(bt - ref), q[i] * __expf(bt)), wk_ = pk2(kk[i] * __expf(fminf(-bt, 80.f)), kk[i] * __expf(fminf(b31 - bt, 80.f)));
            *(LAS unsigned short*)(lds + HA_IQ + tt * 272 + d * 2) = (unsigned short)(wq_ & 0xffffu);
            if (part < 2) *(LAS unsigned short*)(lds + HA_IK0 + tt * 272 + d * 2) = (unsigned short)(wk_ & 0xffffu);
            *(LAS unsigned short*)(lds + HA_IK1 + tt * 272 + d * 2) = (unsigned short)(wk_ >> 16);
            QH[tt * 128] = (bf16)(wq_ >> 16); kh[i] = kk[i] * __expf(bend - bt); }
        v4u k0, k1, v0, v1;
        k0.x = pk2(kh[0], kh[1]); k0.y = pk2(kh[2], kh[3]); k0.z = pk2(kh[4], kh[5]); k0.w = pk2(kh[6], kh[7]); k1.x = pk2(kh[8], kh[9]); k1.y = pk2(kh[10], kh[11]); k1.z = pk2(kh[12], kh[13]); k1.w = pk2(kh[14], kh[15]);
        v0.x = pk2(v[0], v[1]); v0.y = pk2(v[2], v[3]); v0.z = pk2(v[4], v[5]); v0.w = pk2(v[6], v[7]); v1.x = pk2(v[8], v[9]); v1.y = pk2(v[10], v[11]); v1.z = pk2(v[12], v[13]); v1.w = pk2(v[14], v[15]);
        GAS bf16* KHT = (GAS bf16*)(p.ws + WS_HREC) + (size_t)ch * HREC + H_KHT + d * 64 + 16 * part; *(GAS v4u*)KHT = k0; *(GAS v4u*)(KHT + 8) = k1;
        GAS bf16* VHT = (GAS bf16*)(p.ws + WS_HREC) + (size_t)ch * HREC + H_VHT + d * 64 + 16 * part; *(GAS v4u*)VHT = v0; *(GAS v4u*)(VHT + 8) = v1;
        *(LAS v4u*)(lds + HA_IVT + d * 144 + 32 * part) = v0; *(LAS v4u*)(lds + HA_IVT + d * 144 + 32 * part + 16) = v1;
        if (part == 0) ((GAS float*)((GAS bf16*)(p.ws + WS_HREC) + (size_t)ch * HREC + H_DE))[d] = __expf(bend);
    }
    __syncthreads();
    if (wave < 3) { const int ti = wave ? 1 : 0, kr0 = (wave == 2) ? 32 : 0; const LAS unsigned char* imgK = lds + (wave ? HA_IK1 : HA_IK0); f32x16 acc = zero16(); bf16x8v fa_[8], fb_[8];
#pragma unroll
        for (int s = 0; s < 8; ++s) { fa_[s] = frag_nat(lds + HA_IQ, 32 * ti + r, 272, 16 * s, hh); fb_[s] = frag_nat(imgK, kr0 + r, 272, 16 * s, hh); }
        __builtin_amdgcn_sched_barrier(0);
#pragma unroll
        for (int s = 0; s < 8; ++s) acc = MFMA32(fa_[s], fb_[s], acc);
        const int sc_ = kr0 + r;
#pragma unroll
        for (int reg = 0; reg < 16; ++reg) { const int tt = 32 * ti + crow(reg, hh); *(LAS unsigned short*)(lds + HA_IIN + tt * 144 + sc_ * 2) = (unsigned short)f2bf((sc_ <= tt) ? acc[reg] : 0.f); } }
    __syncthreads();
    { const int mt = wave >> 2, nt = wave & 3; f32x16 acc = zero16(); const int nks = mt ? 4 : 2;
      for (int ks = 0; ks < nks; ++ks) { const bf16x8v a = frag_nat(lds + HA_IIN, 32 * mt + r, 144, 16 * ks, hh), bb = frag_nat(lds + HA_IVT, 32 * nt + r, 144, 16 * ks, hh); acc = MFMA32(a, bb, acc); }
      GAS bf16* OI = (GAS bf16*)(p.ws + WS_HREC) + (size_t)ch * HREC + H_OI + 32 * nt + r;
#pragma unroll
      for (int reg = 0; reg < 16; ++reg) OI[(32 * mt + crow(reg, hh)) * 128] = (bf16)f2bf(acc[reg]); }
    __syncthreads();
}

constexpr int GB_NW = 0, GB_QG = 17408, GB_KGT = 34816, GB_QK = 52224, GB_UU = 60928, GB_BUF = 65536;
constexpr int HB_QH = 0, HB_KHT = 17408, HB_VT = 35840, HB_OI = 40448, HB_DE = 49664, HB_BUF = 50176;
__device__ __forceinline__ void gb_chunk(const Params& p, int ch, int sl, int c, const GAS v4u*& src, int& dst, bool& two64) {
    const GAS v4u* rec = (const GAS v4u*)((const GAS bf16*)(p.ws + WS_GREC) + (size_t)ch * GREC);
    if (c < 3584) { const int k = c - 2048; src = rec + c; two64 = c >= 2048; dst = two64 ? GB_KGT + (k >> 3) * 136 + (k & 7) * 16 : (c >> 4) * 272 + (c & 15) * 16; }
    else { const int k = c - 3584; src = rec + (G_UU / 8 + sl * 4) + (k >> 2) * 16 + (k & 3); dst = GB_UU + (k >> 2) * 72 + (k & 3) * 16; two64 = true; }
}
__device__ __forceinline__ void hb_chunk(const Params& p, int ch, int sl, int c, const GAS v4u*& src, int& dst) {
    const GAS v4u* rec = (const GAS v4u*)((const GAS bf16*)(p.ws + WS_HREC) + (size_t)ch * HREC);
    int off;
    if (c < 2048) { const int k = c - 1024; off = c; dst = c < 1024 ? (c >> 4) * 272 + (c & 15) * 16 : HB_KHT + (k >> 3) * 144 + (k & 7) * 16; }
    else if (c < 2304) { const int k = c - 2048; off = H_VHT / 8 + sl * 256 + k; dst = HB_VT + (k >> 3) * 144 + (k & 7) * 16; }
    else if (c < 2560) { const int k = c - 2304; off = H_OI / 8 + sl * 4 + (k >> 2) * 16 + (k & 3); dst = HB_OI + (k >> 2) * 80 + (k & 3) * 16; }
    else { const int k = c - 2560; off = H_DE / 8 + k; dst = HB_DE + k * 16; }
    src = rec + off;
}
template <int MIXER> struct EbRegs { v4u r[MIXER ? 9 : 6]; };
template <int MIXER> __device__ __forceinline__ void eb_load(const Params& p, EbRegs<MIXER>& R, int ch, int sl, int ht, int nth) {
    constexpr int NCH = MIXER ? 3840 : 2592, NR = MIXER ? 9 : 6;
    asm volatile("" : "+v"(ht));
    __builtin_assume(ht >= 0 && ht < nth);
#pragma unroll
    for (int i = 0; i < NR; ++i) { const int c = ht + nth * i; if (c < NCH) { const GAS v4u* src; int dst; bool t64 = false; if (MIXER) gb_chunk(p, ch, sl, c, src, dst, t64); else hb_chunk(p, ch, sl, c, src, dst); R.r[i] = *src; } }
}
template <int MIXER> __device__ __forceinline__ void eb_store(const Params& p, const EbRegs<MIXER>& R, LAS unsigned char* buf, int ch, int sl, int ht, int nth) {
    constexpr int NCH = MIXER ? 3840 : 2592, NR = MIXER ? 9 : 6;
    asm volatile("" : "+v"(ht));
    __builtin_assume(ht >= 0 && ht < nth);
#pragma unroll
    for (int i = 0; i < NR; ++i) { const int c = ht + nth * i; if (c < NCH) { const GAS v4u* src; int dst; bool t64 = false; if (MIXER) gb_chunk(p, ch, sl, c, src, dst, t64); else hb_chunk(p, ch, sl, c, src, dst);
        if (t64) { v2u a, b2; a.x = R.r[i].x; a.y = R.r[i].y; b2.x = R.r[i].z; b2.y = R.r[i].w; *(LAS v2u*)(buf + dst) = a; *(LAS v2u*)(buf + dst + 8) = b2; }
        else *(LAS v4u*)(buf + dst) = R.r[i]; } }
}
#define CHAIN8(ACC, FR, B0_, B1_, B2_, B3_, B4_, B5_, B6_, B7_) do { \
    const bf16x8v _a0 = FR(0), _a1 = FR(1), _a2 = FR(2), _a3 = FR(3); __builtin_amdgcn_sched_barrier(0); \
    const bf16x8v _a4 = FR(4), _a5 = FR(5), _a6 = FR(6), _a7 = FR(7); \
    ACC = MFMA32(_a0, B0_, ACC); ACC = MFMA32(_a1, B1_, ACC); ACC = MFMA32(_a2, B2_, ACC); ACC = MFMA32(_a3, B3_, ACC); __builtin_amdgcn_sched_barrier(0); \
    ACC = MFMA32(_a4, B4_, ACC); ACC = MFMA32(_a5, B5_, ACC); ACC = MFMA32(_a6, B6_, ACC); ACC = MFMA32(_a7, B7_, ACC); } while (0)
template <int MIXER> __device__ __forceinline__ void eb_scan(const Params& p0, LAS unsigned char* lds, int bh, int sl) {
    PHASE_IDS(); Params p = p0; asm volatile("" : "+s"(p.ws)); GLOBAL_PARAMS(p);
    constexpr int BUF = MIXER ? GB_BUF : HB_BUF;
    const int r = lane & 31, hh = lane >> 5, b = bh >> 3, h = bh & 7;
    f32x16 S[4];
#pragma unroll
    for (int kt = 0; kt < 4; ++kt) S[kt] = zero16();
    EbRegs<MIXER> R;
    eb_load<MIXER>(p, R, bh * 32, sl, tid, 512); eb_store<MIXER>(p, R, lds, bh * 32, sl, tid, 512);
    if (wave != 0) eb_load<MIXER>(p, R, bh * 32 + 1, sl, tid - 64, 448);
    __syncthreads();
    constexpr int OST = 131072, OSTB = 5120;
    GAS bf16* OA = (GAS bf16*)(p.ws + WS_OA) + ((size_t)b * T) * 2048 + MIXER * 1024 + h * 128 + sl * 32;
#pragma unroll 1
    for (int n = 0; n < 32; ++n) {
        const int ch = bh * 32 + n; const LAS unsigned char* B = lds + (n & 1) * BUF;
        if (wave != 0) {
            if (n + 1 < 32) eb_store<MIXER>(p, R, lds + ((n + 1) & 1) * BUF, ch + 1, sl, tid - 64, 448);
            if (n + 2 < 32) eb_load<MIXER>(p, R, ch + 2, sl, tid - 64, 448);
            if (n > 0 && tid - 64 < 256) { const int ht = tid - 64, row = ht >> 2, c4 = ht & 3;
                *(GAS v4u*)(OA + (size_t)((n - 1) * 64 + row) * 2048 + c4 * 8) = *(const LAS v4u*)(lds + OST + ((n - 1) & 1) * OSTB + row * 80 + c4 * 16); } }
        else {
            bf16x8v sp[4][2];
#pragma unroll
            for (int kt = 0; kt < 4; ++kt) { sp[kt][0] = kt ? PACK_STEP_L(S[kt], 0) : PACK_STEP(S[kt], 0); sp[kt][1] = PACK_STEP_L(S[kt], 1); }
            LAS unsigned char* orow = lds + OST + (n & 1) * OSTB + r * 2;
            if (MIXER) {
                const float eg = ((const GAS float*)(p.ws + WS_GEND))[ch];
                f32x16 VN[2];
                { unsigned short uu_[2][16];
#pragma unroll
                  for (int mt = 0; mt < 2; ++mt)
#pragma unroll
                    for (int reg = 0; reg < 16; ++reg) uu_[mt][reg] = *(const LAS unsigned short*)(B + GB_UU + (32 * mt + crow(reg, hh)) * 72 + r * 2);
                  __builtin_amdgcn_sched_barrier(0);
#pragma unroll
                  for (int mt = 0; mt < 2; ++mt)
#pragma unroll
                    for (int reg = 0; reg < 16; ++reg) VN[mt][reg] = bflo((unsigned)uu_[mt][reg]); }
#define FR_NW0(i) frag_perm(B + GB_NW, r, 272, 16 * (i), hh)
#define FR_NW1(i) frag_perm(B + GB_NW, 32 + r, 272, 16 * (i), hh)
                CHAIN8(VN[0], FR_NW0, sp[0][0], sp[0][1], sp[1][0], sp[1][1], sp[2][0], sp[2][1], sp[3][0], sp[3][1]);
                CHAIN8(VN[1], FR_NW1, sp[0][0], sp[0][1], sp[1][0], sp[1][1], sp[2][0], sp[2][1], sp[3][0], sp[3][1]);
                bf16x8v vp[2][2];
#pragma unroll
                for (int mt = 1; mt >= 0; --mt) { vp[mt][0] = mt ? PACK_STEP(VN[mt], 0) : PACK_STEP_L(VN[mt], 0); vp[mt][1] = PACK_STEP_L(VN[mt], 1); }
                bf16x8v qkf[2][4];
#pragma unroll
                for (int mt = 0; mt < 2; ++mt)
#pragma unroll
                    for (int m2 = 0; m2 <= mt; ++m2)
#pragma unroll
                        for (int s = 0; s < 2; ++s) qkf[mt][2 * m2 + s] = frag_perm(B + GB_QK, 32 * mt + r, 136, 32 * m2 + 16 * s, hh);
                __builtin_amdgcn_sched_barrier(0);
#pragma unroll
                for (int mt = 0; mt < 2; ++mt) { f32x16 O = zero16();
#define FR_QG(i) frag_perm(B + GB_QG, 32 * mt + r, 272, 16 * (i), hh)
                    CHAIN8(O, FR_QG, sp[0][0], sp[0][1], sp[1][0], sp[1][1], sp[2][0], sp[2][1], sp[3][0], sp[3][1]);
#pragma unroll
                    for (int m2 = 0; m2 <= mt; ++m2)
#pragma unroll
                        for (int s = 0; s < 2; ++s) O = MFMA32(qkf[mt][2 * m2 + s], vp[m2][s], O);
                    __builtin_amdgcn_sched_barrier(0);
                    const bf16x8v oq0 = PACK_STEP(O, 0), oq1 = PACK_STEP_L(O, 1);
#pragma unroll
                    for (int reg = 0; reg < 16; ++reg) *(LAS bf16*)(orow + (32 * mt + crow(reg, hh)) * 80) = (bf16)(reg < 8 ? oq0[reg & 7] : oq1[reg & 7]); }
#define LD_KGT(F, kt_) do { F[0] = frag_perm(B + GB_KGT, 32 * (kt_) + r, 136, 0, hh); F[1] = frag_perm(B + GB_KGT, 32 * (kt_) + r, 136, 16, hh); F[2] = frag_perm(B + GB_KGT, 32 * (kt_) + r, 136, 32, hh); F[3] = frag_perm(B + GB_KGT, 32 * (kt_) + r, 136, 48, hh); } while (0)
#define UP_S(F, kt_) do { _Pragma("unroll") for (int reg = 0; reg < 16; ++reg) S[kt_][reg] *= eg; \
                    S[kt_] = MFMA32(F[0], vp[0][0], S[kt_]); S[kt_] = MFMA32(F[1], vp[0][1], S[kt_]); S[kt_] = MFMA32(F[2], vp[1][0], S[kt_]); S[kt_] = MFMA32(F[3], vp[1][1], S[kt_]); } while (0)
                { bf16x8v fa[4], fb[4];
                  LD_KGT(fa, 0); __builtin_amdgcn_sched_barrier(0);
                  LD_KGT(fb, 1); UP_S(fa, 0); __builtin_amdgcn_sched_barrier(0);
                  LD_KGT(fa, 2); UP_S(fb, 1); __builtin_amdgcn_sched_barrier(0);
                  LD_KGT(fb, 3); UP_S(fa, 2); __builtin_amdgcn_sched_barrier(0);
                  UP_S(fb, 3); }
            } else {
#pragma unroll
                for (int mt = 0; mt < 2; ++mt) { f32x16 O; unsigned short oi_[16];
#pragma unroll
                    for (int reg = 0; reg < 16; ++reg) oi_[reg] = *(const LAS unsigned short*)(B + HB_OI + (32 * mt + crow(reg, hh)) * 80 + r * 2);
                    __builtin_amdgcn_sched_barrier(0);
#pragma unroll
                    for (int reg = 0; reg < 16; ++reg) O[reg] = bflo((unsigned)oi_[reg]);
#define FR_QH(i) frag_perm(B + HB_QH, 32 * mt + r, 272, 16 * (i), hh)
                    CHAIN8(O, FR_QH, sp[0][0], sp[0][1], sp[1][0], sp[1][1], sp[2][0], sp[2][1], sp[3][0], sp[3][1]);
                    __builtin_amdgcn_sched_barrier(0);
                    const bf16x8v oq0 = PACK_STEP(O, 0), oq1 = PACK_STEP_L(O, 1);
#pragma unroll
                    for (int reg = 0; reg < 16; ++reg) *(LAS bf16*)(orow + (32 * mt + crow(reg, hh)) * 80) = (bf16)(reg < 8 ? oq0[reg & 7] : oq1[reg & 7]); }
                { bf16x8v vb[4], fa[4], fb[4];
#pragma unroll
                  for (int ks = 0; ks < 4; ++ks) vb[ks] = frag_nat(B + HB_VT, r, 144, 16 * ks, hh);
#define LD_KHT(F, kt_) do { F[0] = frag_nat(B + HB_KHT, 32 * (kt_) + r, 144, 0, hh); F[1] = frag_nat(B + HB_KHT, 32 * (kt_) + r, 144, 16, hh); F[2] = frag_nat(B + HB_KHT, 32 * (kt_) + r, 144, 32, hh); F[3] = frag_nat(B + HB_KHT, 32 * (kt_) + r, 144, 48, hh); } while (0)
#define UP_SH(F, kt_) do { _Pragma("unroll") for (int q4 = 0; q4 < 4; ++q4) { const f32x4 de = *(const LAS f32x4*)(B + HB_DE + (32 * (kt_) + 8 * q4 + 4 * hh) * 4); \
                        S[kt_][4 * q4] *= de[0]; S[kt_][4 * q4 + 1] *= de[1]; S[kt_][4 * q4 + 2] *= de[2]; S[kt_][4 * q4 + 3] *= de[3]; } \
                    S[kt_] = MFMA32(F[0], vb[0], S[kt_]); S[kt_] = MFMA32(F[1], vb[1], S[kt_]); S[kt_] = MFMA32(F[2], vb[2], S[kt_]); S[kt_] = MFMA32(F[3], vb[3], S[kt_]); } while (0)
                  LD_KHT(fa, 0); __builtin_amdgcn_sched_barrier(0);
                  LD_KHT(fb, 1); UP_SH(fa, 0); __builtin_amdgcn_sched_barrier(0);
                  LD_KHT(fa, 2); UP_SH(fb, 1); __builtin_amdgcn_sched_barrier(0);
                  LD_KHT(fb, 3); UP_SH(fa, 2); __builtin_amdgcn_sched_barrier(0);
                  UP_SH(fb, 3); }
            }
        }
        __syncthreads();
    }
    if (wave != 0 && tid - 64 < 256) { const int ht = tid - 64, row = ht >> 2, c4 = ht & 3;
        *(GAS v4u*)(OA + (size_t)(31 * 64 + row) * 2048 + c4 * 8) = *(const LAS v4u*)(lds + OST + OSTB + row * 80 + c4 * 16); }
    __syncthreads();
}
__device__ __forceinline__ void ec_phase(const Params& p0, int je) {
    PHASE_IDS(); Params p = p0; asm volatile("" : "+s"(p.ws)); GLOBAL_PARAMS(p);     const int gw = blockIdx.x * NWAVES + wave, NGW = gridDim.x * NWAVES;
    const GAS bf16* Z = (const GAS bf16*)(p.ws + WS_Z); const GAS bf16* OA = (const GAS bf16*)(p.ws + WS_OA); GAS bf16* OMIX = (GAS bf16*)(p.ws + WS_OMIX);
    const int sub = lane >> 4, e8 = (lane & 15) * 8;
    const int item0 = gw * 4 + sub, hs = item0 & 15, mixer = hs >> 3, h = hs & 7;
    const GAS float* gn = (mixer ? p.gdn_g : p.hgrn_g) + je * 128 + e8; const f32x4 ga = *(const GAS f32x4*)gn, gb = *(const GAS f32x4*)(gn + 4);
    for (int itb = item0; itb < M * 16; itb += NGW * 16) {
        v4u ow_[4], gz_[4];
#pragma unroll
        for (int u = 0; u < 4; ++u) { const int item = itb + u * NGW * 4; const size_t m = (size_t)((item < M * 16 ? item : item0) >> 4);
            ow_[u] = *(const GAS v4u*)(OA + m * 2048 + hs * 128 + e8); gz_[u] = *(const GAS v4u*)(Z + m * ZE + (mixer ? 7168 : 3072) + h * 128 + e8); }
        __builtin_amdgcn_sched_barrier(0);
#pragma unroll
        for (int u = 0; u < 4; ++u) { const int item = itb + u * NGW * 4; const size_t m = (size_t)(item >> 4); const v4u ow = ow_[u], gz = gz_[u];
            const f32x4 oa = (f32x4){bflo(ow.x), bfhi(ow.x), bflo(ow.y), bfhi(ow.y)}, ob = (f32x4){bflo(ow.z), bfhi(ow.z), bflo(ow.w), bfhi(ow.w)};
            const float ss = row16_sum((oa[0] * oa[0] + oa[1] * oa[1]) + (oa[2] * oa[2] + oa[3] * oa[3]) + (ob[0] * ob[0] + ob[1] * ob[1]) + (ob[2] * ob[2] + ob[3] * ob[3]));
            const float rstd = __builtin_amdgcn_rsqf(ss * (1.0f / 128.0f) + EPS);
            v4u o; o.x = pk2(oa[0] * rstd * ga[0] * silu2_f(bflo(gz.x)), oa[1] * rstd * ga[1] * silu2_f(bfhi(gz.x))); o.y = pk2(oa[2] * rstd * ga[2] * silu2_f(bflo(gz.y)), oa[3] * rstd * ga[3] * silu2_f(bfhi(gz.y)));
            o.z = pk2(ob[0] * rstd * gb[0] * silu2_f(bflo(gz.z)), ob[1] * rstd * gb[1] * silu2_f(bfhi(gz.z))); o.w = pk2(ob[2] * rstd * gb[2] * silu2_f(bflo(gz.w)), ob[3] * rstd * gb[3] * silu2_f(bfhi(gz.w)));
            if (item < M * 16) *(GAS v4u*)(OMIX + m * D + hs * 128 + e8) = o; }
    }
}

constexpr size_t WS_W1T = 972 * MiB, WS_W2T = 976 * MiB, WS_WXT = 977 * MiB;
typedef short bf16x8g __attribute__((ext_vector_type(8)));
#define MFMA16(a, b, c) __builtin_amdgcn_mfma_f32_16x16x32_bf16((a), (b), (c), 0, 0, 0)
constexpr int OC_RED = 0, OC_HID = 65536;
__device__ __forceinline__ void ocmp_fast(const Params& p0, LAS unsigned char* lds, int unit, int jo) {
    PHASE_IDS(); Params p = p0; asm volatile("" : "+s"(p.ws)); GLOBAL_PARAMS(p);
    const int kv = unit >> 7, b = (unit >> 5) & 3, g = (unit >> 3) & 3, jb = unit & 7, r16 = lane & 15, q4 = lane >> 4;
    const GAS bf16* Z = (const GAS bf16*)(p.ws + WS_Z); GAS bf16* CMP = (GAS bf16*)(p.ws + WS_CMP);
    const int j = 16 * jb + r16, jc = j < 126 ? j : 126;
    const GAS bf16* zbase = Z + ((size_t)b * T + 16 * jc) * ZO + 2048 + kv * 512 + g * 128 + 8 * q4;
    const GAS bf16* w1t = (const GAS bf16*)(p.ws + WS_W1T) + (size_t)(jo * 2 + kv) * 128 * 4096 + (size_t)r16 * 4096 + 8 * q4;
    const GAS float* pos = p.cmp_pos + (size_t)(jo * 2 + kv) * 32 * 128 + 8 * q4;
    f32x4 acc[8];
#pragma unroll
    for (int nt = 0; nt < 8; ++nt) acc[nt] = (f32x4){0.f, 0.f, 0.f, 0.f};
    v4u zw[2][2]; f32x4 pa[2][2], pb[2][2]; bf16x8g bb[2][2][8];
#define OC_LOAD_(kb_, bu) { _Pragma("unroll") for (int u = 0; u < 2; ++u) { const int kg = wave * 16 + 2 * (kb_) + u, l = kg >> 2, d0 = (kg & 3) * 32; \
        zw[bu][u] = *(const GAS v4u*)(zbase + (size_t)l * ZO + d0); pa[bu][u] = *(const GAS f32x4*)(pos + l * 128 + d0); pb[bu][u] = *(const GAS f32x4*)(pos + l * 128 + d0 + 4); \
        _Pragma("unroll") for (int nt = 0; nt < 8; ++nt) bb[bu][u][nt] = *(const GAS bf16x8g*)(w1t + (size_t)nt * 16 * 4096 + kg * 32); } }
    OC_LOAD_(0, 0)
#pragma unroll
    for (int kb = 0; kb < 8; ++kb) {
        if (kb < 7) { if (kb & 1) OC_LOAD_(kb + 1, 0) else OC_LOAD_(kb + 1, 1) }
        __builtin_amdgcn_sched_barrier(0);
#pragma unroll
        for (int u = 0; u < 2; ++u) { const f32x4 p0 = pa[kb & 1][u], p1 = pb[kb & 1][u]; const v4u z = zw[kb & 1][u];
            v4u aw; aw.x = pk2s(bflo(z.x) + p0[0], bfhi(z.x) + p0[1]); aw.y = pk2s(bflo(z.y) + p0[2], bfhi(z.y) + p0[3]); aw.z = pk2s(bflo(z.z) + p1[0], bfhi(z.z) + p1[1]); aw.w = pk2s(bflo(z.w) + p1[2], bfhi(z.w) + p1[3]);
            const bf16x8g a = __builtin_bit_cast(bf16x8g, aw);
#pragma unroll
            for (int nt = 0; nt < 8; ++nt) acc[nt] = MFMA16(a, bb[kb & 1][u][nt], acc[nt]); }
        __builtin_amdgcn_sched_barrier(0);
    }
#undef OC_LOAD_
    LAS float* red = (LAS float*)(lds + OC_RED) + wave * 2048;
#pragma unroll
    for (int nt = 0; nt < 8; ++nt)
#pragma unroll
        for (int reg = 0; reg < 4; ++reg) red[(q4 * 4 + reg) * 128 + 16 * nt + r16] = acc[nt][reg];
    __syncthreads();
    { const int row = tid >> 5, c4 = (tid & 31) * 4; f32x4 s = (f32x4){0.f, 0.f, 0.f, 0.f};
#pragma unroll
      for (int w = 0; w < 8; ++w) s = s + *(const LAS f32x4*)(lds + OC_RED + (w * 2048 + row * 128 + c4) * 4);
      v2u hw; hw.x = pk2(silu2_f(s[0]), silu2_f(s[1])); hw.y = pk2(silu2_f(s[2]), silu2_f(s[3]));
      *(LAS v2u*)(lds + OC_HID + row * 272 + c4 * 2) = hw; }
    __syncthreads();
    { const GAS bf16* w2t = (const GAS bf16*)(p.ws + WS_W2T) + (size_t)(jo * 2 + kv) * 128 * 128 + (size_t)(16 * wave + r16) * 128 + 8 * q4;
      f32x4 o = (f32x4){0.f, 0.f, 0.f, 0.f};
#pragma unroll
      for (int ks = 0; ks < 4; ++ks) { const bf16x8g a = *(const LAS bf16x8g*)(lds + OC_HID + r16 * 272 + (32 * ks + 8 * q4) * 2); const bf16x8g bb = *(const GAS bf16x8g*)(w2t + 32 * ks); o = MFMA16(a, bb, o); }
#pragma unroll
      for (int reg = 0; reg < 4; ++reg) { const int jr = 16 * jb + q4 * 4 + reg;
          CMP[((size_t)((kv * 4 + b) * 4 + g) * 128 + jr) * 128 + 16 * wave + r16] = (jr < 127) ? (bf16)f2bf(o[reg]) : (bf16)0; } }
    __syncthreads();
}

template <int NT> __device__ __forceinline__ void gate_gemm(const GAS bf16* U, const GAS bf16* wxt, LAS float* red, int tile, int kq, int lane) {
    const int r16 = lane & 15, q4 = lane >> 4;
    const GAS bf16* arow = U + (size_t)(tile * 16 + r16) * D + kq * 512 + 8 * q4; const GAS bf16* brow = wxt + (size_t)r16 * D + kq * 512 + 8 * q4;
    f32x4 acc[NT];
#pragma unroll
    for (int nt = 0; nt < NT; ++nt) acc[nt] = (f32x4){0.f, 0.f, 0.f, 0.f};
    constexpr int KB = NT == 1 ? 8 : 4;
    bf16x8g fa[2][KB], fb[2][KB][NT];
#define GG_LOAD_(bt, bu) { _Pragma("unroll") for (int k = 0; k < KB; ++k) { fa[bu][k] = *(const GAS bf16x8g*)(arow + 32 * ((bt) * KB + k)); _Pragma("unroll") for (int nt = 0; nt < NT; ++nt) fb[bu][k][nt] = *(const GAS bf16x8g*)(brow + (size_t)nt * 16 * D + 32 * ((bt) * KB + k)); } }
    GG_LOAD_(0, 0)
#pragma unroll
    for (int bt = 0; bt < 16 / KB; ++bt) {
        if (bt + 1 < 16 / KB) { if (bt & 1) GG_LOAD_(bt + 1, 0) else GG_LOAD_(bt + 1, 1) }
        __builtin_amdgcn_sched_barrier(0);
#pragma unroll
        for (int k = 0; k < KB; ++k)
#pragma unroll
            for (int nt = 0; nt < NT; ++nt) acc[nt] = MFMA16(fa[bt & 1][k], fb[bt & 1][k][nt], acc[nt]);
        __builtin_amdgcn_sched_barrier(0);
    }
#undef GG_LOAD_
#pragma unroll
    for (int nt = 0; nt < NT; ++nt)
#pragma unroll
        for (int reg = 0; reg < 4; ++reg) red[(q4 * 4 + reg) * 48 + 16 * nt + r16] = acc[nt][reg];
}
__device__ __forceinline__ void gate_phase(const Params& p0, LAS unsigned char* lds, int odd, int j, int first, int step) {
    PHASE_IDS(); Params p = p0; asm volatile("" : "+s"(p.ws)); GLOBAL_PARAMS(p);
    const GAS bf16* U = (const GAS bf16*)(p.ws + WS_U); GAS float* gates = (GAS float*)(p.ws + WS_GATES);
    const int tsel = wave >> 2, kq = wave & 3, ncol = odd ? 48 : 16;
    if (first < 0) return;
    for (int t2 = first; t2 < 256; t2 += step) {
        const int tile = 2 * t2 + tsel; LAS float* red = (LAS float*)lds + wave * 768;
        if (odd) gate_gemm<3>(U, (const GAS bf16*)(p.ws + WS_WXT) + 2 * 16 * D + (size_t)j * 48 * D, red, tile, kq, lane);
        else gate_gemm<1>(U, (const GAS bf16*)(p.ws + WS_WXT) + (size_t)j * 16 * D, red, tile, kq, lane);
        __syncthreads();
        for (int idx = tid; idx < 2 * 16 * ncol; idx += NWAVES * 64) { const int ts = idx / (16 * ncol), rem = idx % (16 * ncol), row = rem / ncol, col = rem % ncol;
            const LAS float* rb = (const LAS float*)lds + (ts * 4) * 768 + row * 48 + col;
            gates[(size_t)((2 * t2 + ts) * 16 + row) * 64 + col] = (rb[0] + rb[768]) + (rb[2 * 768] + rb[3 * 768]); }
        __syncthreads();
    }
}
__device__ __forceinline__ void tr_cols(const GAS float* W, int ldw, int col0, int ncols, GAS bf16* WT, int gtid, int ngt, const GAS float* gk) {
    for (int it = gtid; it < ncols * 256; it += ngt) { const int n = it % ncols, k8 = (it / ncols) * 8; const GAS float* s = W + (size_t)k8 * ldw + col0 + n;
        const GAS float* gq = gk + k8;
        v4u o; o.x = pk2(s[0] * gq[0], s[(size_t)ldw] * gq[1]); o.y = pk2(s[(size_t)2 * ldw] * gq[2], s[(size_t)3 * ldw] * gq[3]); o.z = pk2(s[(size_t)4 * ldw] * gq[4], s[(size_t)5 * ldw] * gq[5]); o.w = pk2(s[(size_t)6 * ldw] * gq[6], s[(size_t)7 * ldw] * gq[7]);
        *(GAS v4u*)(WT + (size_t)n * D + k8) = o; }
}
__device__ __forceinline__ void p0_extra(const Params& p0, LAS unsigned char* lds) {
    PHASE_IDS(); Params p = p0; asm volatile("" : "+s"(p.ws)); GLOBAL_PARAMS(p);     const int gw = blockIdx.x * NWAVES + wave, NGW = gridDim.x * NWAVES;
    LAS float* scr = (LAS float*)(lds + wave * 16384);
    for (int idx = 0; idx < 4; ++idx) {
        tr_matrix(p.cmp_w1 + (size_t)idx * 4096 * 128, 128, 4096, 128, (GAS bf16*)(p.ws + WS_W1T) + (size_t)idx * 128 * 4096, 0, scr, gw, NGW, lane);
        tr_matrix(p.cmp_w2 + (size_t)idx * 128 * 128, 128, 128, 128, (GAS bf16*)(p.ws + WS_W2T) + (size_t)idx * 128 * 128, 0, scr, gw, NGW, lane);
    }
    const int gtid = blockIdx.x * (NWAVES * 64) + tid, ngt = gridDim.x * NWAVES * 64;
    for (int j = 0; j < 2; ++j) {
        tr_cols(p.ab_w_in + (size_t)j * D * EVEN_IN, EVEN_IN, ZE, 16, (GAS bf16*)(p.ws + WS_WXT) + (size_t)j * 16 * D, gtid, ngt, p.norm_g + (size_t)((2 * j) * 4 + 0) * D);
        tr_cols(p.nsa_w_in + (size_t)j * D * ODD_IN, ODD_IN, ZO, 48, (GAS bf16*)(p.ws + WS_WXT) + 2 * 16 * D + (size_t)j * 48 * D, gtid, ngt, p.norm_g + (size_t)((2 * j + 1) * 4 + 0) * D);
    }
}

__global__ void __launch_bounds__(NWAVES * 64, 2) fwd(Params p) {
    extern __shared__ __attribute__((aligned(16))) unsigned char lds_raw[];
    LAS unsigned char* lds = (LAS unsigned char*)lds_raw;
    const int G = gridDim.x, bx = blockIdx.x;
    volatile LAS unsigned* MISC = (volatile LAS unsigned*)(lds + MISC_OFF);
    for (int u = threadIdx.x; u < (LDS_BYTES - LDSCTL_OFF) / 4; u += NWAVES * 64) ((LAS unsigned*)(lds + LDSCTL_OFF))[u] = 0u;
    __syncthreads();
    unsigned* ctl = (unsigned*)(p.ws + WS_CTL);
    XcdBarrier bar; bar.bar = ctl + CW_BAR; bar.x = 0; bar.st = nullptr;
    if (!MK_PER_PHASE) bar = xcd_barrier_post(ctl + CW_BAR, MISC + 8);
#ifndef REPEAT_MASK
#define REPEAT_MASK 0
#endif
    const int lo = MK_PER_PHASE ? p.ph_lo : 0, hi = MK_PER_PHASE ? p.ph_hi : N_PHASES;
#define IN(k) (lo <= (k) && (k) < hi)
#define SEAM(k) do { if (IN(k) && IN((k) + 1)) { XcdBarrier bb_ = bar; asm volatile("" : "+s"(bb_.bar), "+s"(bb_.x));     \
    xcd_barrier(bb_); if (REPEAT_MASK & 512) xcd_barrier(bb_); } } while (0)

#ifndef OATT_FAST
#define OATT_FAST 1
#endif
#ifndef E_PARTS
#define E_PARTS 31
#endif
#define EP(b) ((E_PARTS & (b)) != 0)
#ifndef OCMP_FAST
#define OCMP_FAST 1
#endif
#ifndef ESCAN_FAST
#define ESCAN_FAST 1
#endif
#ifndef SKIP_MASK
#define SKIP_MASK 0
#endif
#define RP(b) (((REPEAT_MASK & (b)) != 0) ? 2 : 1)
#define SK(b) ((SKIP_MASK & (b)) != 0)
    if (IN(0)) {
        if (!SK(1)) for (int rp = 0; rp < RP(1); ++rp) { p0_prologue(p, lds, true); p0_extra(p, lds); }
        if (!SK(2)) nrm_phase<false, true, true, false>(p.x, nullptr, nullptr, nullptr, (GAS bf16*)(p.ws + WS_U), (GAS float*)(p.ws + WS_RS));
    }
    SEAM(0);

#pragma unroll 1
    for (int L = 0; L < 4; ++L) {
        const int odd = L & 1, j = L >> 1, base = 1 + 9 * L;
        GAS unsigned char* ws = p.ws; asm volatile("" : "+s"(ws)); ws = gptr(ws);
        GAS bf16* U = (GAS bf16*)(ws + WS_U); GAS bf16* Z = (GAS bf16*)(ws + WS_Z); GAS bf16* OMIX = (GAS bf16*)(ws + WS_OMIX); GAS bf16* MM = (GAS bf16*)(ws + WS_MM); GAS bf16* HID = (GAS bf16*)(ws + WS_HID);
        if (IN(base + 0)) {
            const int N = odd ? ZO : ZE;
            const GAS bf16* Bt = odd ? (const GAS bf16*)(ws + WS_WIN_O) + (size_t)j * ZO * D : (const GAS bf16*)(ws + WS_WIN_E) + (size_t)j * ZE * D;
            pg8::Gemm g{(const pg8::bf16_t*)(U), (const pg8::bf16_t*)(Bt), M, N, D}; pg8::StaticOrder S; S.init(M, N, G, bx);
            pg8::EpiBf16Plain E{Z, N};
            if (!SK(4)) for (int rp = 0; rp < RP(4) * RP(4096); ++rp) pg8::gemm_phase<pg8::EpiBf16Plain, pg8::StaticOrder, true, true>(lds, g, S, E);
            { const int nun = (M / 256) * (N / 256), rem = nun % G;
              if (!SK(2)) { if (rem == 0) gate_phase(p, lds, odd, j, bx, G); else gate_phase(p, lds, odd, j, bx >= rem ? bx - rem : -1, G - rem); } }
        }
        SEAM(base + 0);
        if (IN(base + 1)) {
            if (odd) { for (int rp = 0; rp < RP(16); ++rp) for (int unit = bx; unit < 256; unit += G) if (!SK(16)) { if (OCMP_FAST) ocmp_fast(p, lds, unit, j); else ocmp_slow(p, lds, unit, j); } }
            else {
#if ESCAN_FAST
                for (int rp = 0; rp < RP(8) * RP(64); ++rp) for (int u = bx; u < 2048; u += G) if (!SK(8)) { if (u < 1024) { if (EP(1)) for (int r2 = 0; r2 < RP(1024); ++r2) ea_gdn(p, lds, u, j); } else { if (EP(2)) for (int r2 = 0; r2 < RP(2048); ++r2) ea_hgrn(p, lds, u - 1024, j); } }
#else
                for (int rp = 0; rp < RP(8); ++rp) for (int unit = bx; unit < 64; unit += G) if (!SK(8)) escan_slow(p, lds, unit, j);
#endif
            }
        }
        SEAM(base + 1);
        if (IN(base + 2)) {
            if (odd) {
#if OATT_FAST
                for (int rp = 0; rp < RP(32); ++rp) for (int u = bx; u < 512; u += G) { const int bq = u & 255, rnd = u >> 8, bg = (bq & 7) * 2 + ((bq >> 3) & 1), pp = bq >> 4;
                    if (!SK(32)) oatt_fast(p, lds, bg >> 2, bg & 3, rnd ? 31 - pp : pp); }
#else
                for (int rp = 0; rp < RP(32); ++rp) for (int unit = bx; unit < 4096; unit += G) if (!SK(32)) oatt_slow(p, lds, unit);
#endif
            } else {
#if ESCAN_FAST
                for (int rp = 0; rp < RP(8) * RP(128); ++rp) for (int s = bx; s < 256; s += G) if (!SK(8)) { const int xc = s & 7, kk = (s >> 3) & 15, bh = xc * 4 + (kk >> 2), sl = kk & 3;
                    if (s < 128) { if (EP(4)) eb_scan<1>(p, lds, bh, sl); } else { if (EP(8)) eb_scan<0>(p, lds, bh, sl); } }
#endif
            }
        }
        SEAM(base + 2);
        if (IN(base + 3)) {
#if ESCAN_FAST
            if (!odd && !SK(8) && EP(16)) for (int rp = 0; rp < RP(256); ++rp) ec_phase(p, j);
#endif
        }
        if (!odd) SEAM(base + 3);
        if (IN(base + 4)) {
            const GAS bf16* Bt = (odd ? (const GAS bf16*)(ws + WS_WOUT_O) : (const GAS bf16*)(ws + WS_WOUT_E)) + (size_t)j * D * D;
            pg8::Gemm g{(const pg8::bf16_t*)(OMIX), (const pg8::bf16_t*)(Bt), M, D, D}; pg8::StaticOrder S; S.init(M, D, G, bx);
            pg8::EpiBf16Plain E{MM, D};
            if (!SK(4)) for (int rp = 0; rp < RP(4) * RP(8192); ++rp) pg8::gemm_phase<pg8::EpiBf16Plain, pg8::StaticOrder, true, true>(lds, g, S, E);
        }
        SEAM(base + 4);
        if (IN(base + 5) && !SK(2)) { const GAS float* g_res = p.norm_g + (size_t)(L * 4 + 1) * D; GAS float* RS = (GAS float*)(ws + WS_RS);
            if (L == 0) nrm_phase<true, true, true, false>(p.x, nullptr, MM, g_res, U, RS); else nrm_phase<true, true, false, false>(nullptr, nullptr, MM, g_res, U, RS); }
        SEAM(base + 5);
        if (IN(base + 6)) {
            const bool split = CONV_SPLIT_G > 0 && L < 3 && G > CONV_SPLIT_G; const int GG = split ? CONV_SPLIT_G : G;
            if (split && bx >= GG) { if (!SK(1)) conv_layer<true>(p, lds, L + 1, 0, 3, bx - GG, G - GG); }
            else {
            pg8::Gemm g{(const pg8::bf16_t*)(U), (const pg8::bf16_t*)((const GAS bf16*)(ws + WS_WGU) + (size_t)L * 2 * DFF * D), M, 2 * DFF, D}; pg8::StaticOrder S; S.init(M, 2 * DFF, GG, bx);
            pg8::EpiSwiglu E{HID, DFF};
#ifdef GU_COLD_PROBE
            { pg8::Gemm g2{(const pg8::bf16_t*)(U), (const pg8::bf16_t*)((const GAS bf16*)(ws + WS_WGU) + (size_t)((L + 2) & 3) * 2 * DFF * D), M, 2 * DFF, D}; pg8::EpiSwiglu E2{(GAS bf16*)(ws + 752 * MiB), DFF};
              pg8::gemm_phase<pg8::EpiSwiglu, pg8::StaticOrder, true, true>(lds, g2, S, E2); }
#endif
            if (!SK(4)) for (int rp = 0; rp < RP(4) * RP(16384); ++rp) pg8::gemm_phase<pg8::EpiSwiglu, pg8::StaticOrder, true, true>(lds, g, S, E);
            }
        }
        SEAM(base + 6);
        if (IN(base + 7)) {
            pg8::Gemm g{(const pg8::bf16_t*)(HID), (const pg8::bf16_t*)((const GAS bf16*)(ws + WS_WDN) + (size_t)L * D * DFF), M, D, DFF}; pg8::StaticOrder S; S.init(M, D, G, bx);
            pg8::EpiBf16Plain E{MM, D};
            if (!SK(4)) for (int rp = 0; rp < RP(4) * RP(32768); ++rp) pg8::gemm_phase<pg8::EpiBf16Plain, pg8::StaticOrder, true, true>(lds, g, S, E);
        }
        SEAM(base + 7);
        if (IN(base + 8) && !SK(2)) {
            const GAS float* g_res = p.norm_g + (size_t)(L * 4 + 3) * D; GAS float* RS = (GAS float*)(ws + WS_RS);
            if (L == 3) nrm_phase<true, false, false, true>(nullptr, p.out, MM, g_res, U, RS);
            else nrm_phase<true, true, false, false>(nullptr, nullptr, MM, g_res, U, RS);
        }
        SEAM(base + 8);
    }
#undef IN
#undef SEAM
}

extern "C" void kernel_launch(void* const* d_in, const int* in_sizes, int n_in, void* d_out, int out_size, void* d_ws, size_t ws_size, hipStream_t stream) {
    static int grid = 0;
    if (grid == 0) {
        if (n_in != 17 || in_sizes[0] != M * D || out_size != M * D || ws_size < WS_END) { fprintf(stderr, "kernel_launch: unexpected shapes (n_in %d, in0 %d, out %d, ws %zu); nothing launched\n", n_in, n_in > 0 ? in_sizes[0] : -1, out_size, ws_size); grid = -1; return; }
        int dev = 0, cus = 0, per_cu = 0;
        if (hipGetDevice(&dev) != hipSuccess || hipDeviceGetAttribute(&cus, hipDeviceAttributeMultiprocessorCount, dev) != hipSuccess) { grid = -1; return; }
        if (hipFuncSetAttribute((const void*)fwd, hipFuncAttributeMaxDynamicSharedMemorySize, LDS_BYTES) != hipSuccess) { fprintf(stderr, "kernel_launch: hipFuncSetAttribute failed\n"); grid = -1; return; }
        if (hipOccupancyMaxActiveBlocksPerMultiprocessor(&per_cu, (const void*)fwd, NWAVES * 64, LDS_BYTES) != hipSuccess || per_cu < 1)
            fprintf(stderr, "kernel_launch: note: occupancy query reports %d workgroups per CU\n", per_cu);
        (void)hipGetLastError();
        grid = cus;
    }
    if (grid < 0) return;
    if (hipMemsetAsync((char*)d_ws + WS_CTL, 0, CTL_ZERO_BYTES, stream) != hipSuccess) return;
    Params p{};
    p.x = (const GAS float*)d_in[0]; p.norm_g = (const GAS float*)d_in[1]; p.ab_w_in = (const GAS float*)d_in[2]; p.hgrn_lb = (const GAS float*)d_in[3]; p.conv_w = (const GAS float*)d_in[4];
    p.a_log = (const GAS float*)d_in[5]; p.dt_bias = (const GAS float*)d_in[6]; p.hgrn_g = (const GAS float*)d_in[7]; p.gdn_g = (const GAS float*)d_in[8]; p.ab_w_out = (const GAS float*)d_in[9];
    p.nsa_w_in = (const GAS float*)d_in[10]; p.cmp_pos = (const GAS float*)d_in[11]; p.cmp_w1 = (const GAS float*)d_in[12]; p.cmp_w2 = (const GAS float*)d_in[13]; p.nsa_w_out = (const GAS float*)d_in[14];
    p.w_gu = (const GAS float*)d_in[15]; p.w_dn = (const GAS float*)d_in[16];
    p.out = (GAS float*)d_out; p.ws = (GAS unsigned char*)d_ws;
#if MK_PER_PHASE
#ifndef MK_NPH
#define MK_NPH N_PHASES
#endif
    for (int ph = 0; ph < MK_NPH; ++ph) { p.ph_lo = ph; p.ph_hi = ph + 1; hipLaunchKernelGGL(fwd, dim3(grid), dim3(NWAVES * 64), LDS_BYTES, stream, p); }
#else
    p.ph_lo = 0; p.ph_hi = N_PHASES;
    hipLaunchKernelGGL(fwd, dim3(grid), dim3(NWAVES * 64), LDS_BYTES, stream, p);
#endif
    const hipError_t le = hipPeekAtLastError();
    if (le != hipSuccess) fprintf(stderr, "kernel_launch: launch failed: %s\n", hipGetErrorName(le));
}
```
